# Optimizing an MI355X kernel written in HIP

```python
import jax, jax.numpy as jnp
from jax import lax
import numpy as np

D_MODEL = 1024
BATCH = 32
SEQ = 2048
DEPTH = 2

F32 = jnp.float32
N_MEM = 256
HEAD_DIM = 64
ROPE_THETA = 10000.0
EPS = 1e-6
NEG_INF = -1e30
POS_INF = 1e30
Q_BLOCK = 128

A_HEADS = 8
A_KV_HEADS = 2
A_WINDOW = 128
A_WIDTH = A_HEADS * HEAD_DIM
A_KV_WIDTH = A_KV_HEADS * HEAD_DIM

B_WIDTH = 512
B_BLOCKS = 8
B_BLOCK_DIM = B_WIDTH // B_BLOCKS
B_CONV = 4
B_C = 8.0

M_HEADS = 4
M_WIDTH = M_HEADS * HEAD_DIM

C_HEADS = 4
C_HEAD_DIM = 128
C_WIDTH = C_HEADS * C_HEAD_DIM
C_CHUNK = 64

D_HEADS = 8
D_KV_HEADS = 2
D_WIDTH = D_HEADS * HEAD_DIM
D_KV_WIDTH = D_KV_HEADS * HEAD_DIM
CMP_LEN = 32
CMP_STRIDE = 16
CMP_HIDDEN = 128
SEL_LEN = 64
SEL_TOPK = 4
SEL_Q_BLOCK = 64
D_WINDOW = 512
D_BRANCHES = 3

EVEN_SPLITS = [A_WIDTH, A_KV_WIDTH, A_KV_WIDTH, A_WIDTH, B_WIDTH, B_WIDTH, M_WIDTH, M_WIDTH]
ODD_SPLITS = [C_WIDTH, C_WIDTH, C_WIDTH, C_WIDTH, D_WIDTH] + [D_KV_WIDTH] * 6 + [D_BRANCHES * D_HEADS, D_WIDTH, M_WIDTH, M_WIDTH]
EVEN_IN = sum(EVEN_SPLITS)
ODD_IN = sum(ODD_SPLITS)
EVEN_MIX = A_WIDTH + B_WIDTH + M_WIDTH
ODD_MIX = C_WIDTH + D_WIDTH + M_WIDTH
N_EVEN = (DEPTH + 1) // 2
N_ODD = DEPTH // 2

kernel_name = "hybrid_swa_rglru_hgrn2_nsa_trunk"


def rms_norm(x, g):
    xf = x.astype(F32)
    y = xf * lax.rsqrt(jnp.mean(xf * xf, axis=-1, keepdims=True) + EPS)
    return (y * g.astype(F32)).astype(x.dtype)


def rope(x, pos):
    half = x.shape[-1] // 2
    inv = ROPE_THETA ** (-jnp.arange(half, dtype=F32) / half)
    ang = pos.astype(F32)[:, None] * inv[None, :]
    cos = jnp.cos(ang)[:, None, :]
    sin = jnp.sin(ang)[:, None, :]
    x1 = x[..., :half].astype(F32)
    x2 = x[..., half:].astype(F32)
    return jnp.concatenate([x1 * cos - x2 * sin, x2 * cos + x1 * sin], axis=-1).astype(x.dtype)


def split_cols(z, widths):
    return jnp.split(z, [int(c) for c in np.cumsum(widths)[:-1]], axis=-1)


def banded_attention(q, k, v, window, sinks=None):
    B_, S_, Hkv, G, hd = q.shape
    pad = -(-(window - 1) // Q_BLOCK) * Q_BLOCK
    span = pad + Q_BLOCK
    kp = jnp.pad(k, ((0, 0), (pad, 0), (0, 0), (0, 0)))
    vp = jnp.pad(v, ((0, 0), (pad, 0), (0, 0), (0, 0)))
    scale = hd ** -0.5

    def one_block(j):
        start = j * Q_BLOCK
        qb = lax.dynamic_slice_in_dim(q, start, Q_BLOCK, axis=1)
        kb = lax.dynamic_slice_in_dim(kp, start, span, axis=1)
        vb = lax.dynamic_slice_in_dim(vp, start, span, axis=1)
        s = jnp.einsum('bqkgd,bskd->bkgqs', qb, kb).astype(F32) * scale
        tq = start + jnp.arange(Q_BLOCK)
        ts = start - pad + jnp.arange(span)
        rel = tq[:, None] - ts[None, :]
        mask = (rel >= 0) & (rel < window) & (ts[None, :] >= 0)
        s = jnp.where(mask, s, NEG_INF)
        if sinks is None:
            p = jax.nn.softmax(s, axis=-1)
        else:
            sink = sinks.astype(F32).reshape(Hkv, G)[None, :, :, None, None]
            m = jnp.maximum(jnp.max(s, axis=-1, keepdims=True), sink)
            e = jnp.exp(s - m)
            p = e / (jnp.sum(e, axis=-1, keepdims=True) + jnp.exp(sink - m))
        return jnp.einsum('bkgqs,bskd->bqkgd', p.astype(vb.dtype), vb)

    out = lax.map(one_block, jnp.arange(S_ // Q_BLOCK))
    return jnp.moveaxis(out, 0, 1).reshape(B_, S_, Hkv, G, hd)


def swa_sink_attention(q, k, v, qn, kn, sinks, pos):
    B_, S_, _ = q.shape
    G = A_HEADS // A_KV_HEADS
    q = rope(rms_norm(q.reshape(B_, S_, A_HEADS, HEAD_DIM), qn), pos).reshape(B_, S_, A_KV_HEADS, G, HEAD_DIM)
    k = rope(rms_norm(k.reshape(B_, S_, A_KV_HEADS, HEAD_DIM), kn), pos)
    v = v.reshape(B_, S_, A_KV_HEADS, HEAD_DIM)
    o = banded_attention(q, k, v, A_WINDOW, sinks)
    return o.reshape(B_, S_, A_WIDTH)


def rglru(xb, conv_w, conv_b, w_r, b_r, w_i, b_i, lam):
    B_, S_, W = xb.shape
    xc = lax.conv_general_dilated(xb, conv_w[:, None, :], window_strides=(1,), padding=[(B_CONV - 1, 0)],
                                  dimension_numbers=('NWC', 'WIO', 'NWC'), feature_group_count=W) + conv_b
    xh = xc.reshape(B_, S_, B_BLOCKS, B_BLOCK_DIM)
    r = jax.nn.sigmoid(jnp.einsum('bshi,hij->bshj', xh, w_r).reshape(B_, S_, W) + b_r).astype(F32)
    i = jax.nn.sigmoid(jnp.einsum('bshi,hij->bshj', xh, w_i).reshape(B_, S_, W) + b_i)
    log_a = -B_C * r * jax.nn.softplus(-lam.astype(F32))
    a = jnp.exp(log_a)
    u = jnp.sqrt(-jnp.expm1(2.0 * log_a)) * (i * xc).astype(F32)

    def combine(c1, c2):
        a1, b1 = c1
        a2, b2 = c2
        return a1 * a2, a2 * b1 + b2

    _, h = lax.associative_scan(combine, (a, u), axis=1)
    return h.astype(xb.dtype)


def memory_cross_attention(qm, mem_n, w_mem_kv, qn, kn):
    B_, S_, _ = qm.shape
    N_ = mem_n.shape[1]
    q = rms_norm(qm.reshape(B_, S_, M_HEADS, HEAD_DIM), qn)
    km, vm = jnp.split(jnp.einsum('bnd,de->bne', mem_n, w_mem_kv), 2, axis=-1)
    km = rms_norm(km.reshape(B_, N_, M_HEADS, HEAD_DIM), kn)
    vm = vm.reshape(B_, N_, M_HEADS, HEAD_DIM)
    s = jnp.einsum('bshd,bnhd->bhsn', q, km).astype(F32) * HEAD_DIM ** -0.5
    p = jax.nn.softmax(s, axis=-1)
    o = jnp.einsum('bhsn,bnhd->bshd', p.astype(vm.dtype), vm)
    return o.reshape(B_, S_, M_WIDTH)


def hgrn_lower_bounds(p):
    c = jnp.cumsum(jax.nn.softmax(p.astype(F32), axis=0), axis=0)
    return c - c[0:1]


def hgrn2(q, f_logit, i_in, lb, o_gain):
    B_, S_, _ = q.shape
    nc = S_ // C_CHUNK
    f = lb + (1.0 - lb) * jax.nn.sigmoid(f_logit.astype(F32))
    log_f = jnp.log(f)
    k = 1.0 - f
    qf = jax.nn.silu(q.astype(F32))
    v = i_in.astype(F32)

    def to_chunks(t):
        return t.reshape(B_, nc, C_CHUNK, C_HEADS, C_HEAD_DIM).transpose(1, 0, 3, 2, 4)

    causal = jnp.tril(jnp.ones((C_CHUNK, C_CHUNK), dtype=bool))

    def step(state, inp):
        qc, kc, vc, gc = inp
        b = jnp.cumsum(gc, axis=2)
        o_inter = jnp.einsum('bhtk,bhkv->bhtv', qc * jnp.exp(b), state)
        diff = b[:, :, :, None, :] - b[:, :, None, :, :]
        decay = jnp.exp(jnp.where(causal[:, :, None], diff, NEG_INF))
        attn = jnp.einsum('bhtk,bhsk,bhtsk->bhts', qc, kc, decay)
        o_intra = jnp.einsum('bhts,bhsv->bhtv', attn, vc)
        b_last = b[:, :, -1:, :]
        state = jnp.exp(b_last[:, :, 0, :])[..., None] * state + jnp.einsum('bhsk,bhsv->bhkv', kc * jnp.exp(b_last - b), vc)
        return state, o_inter + o_intra

    init = jnp.zeros((B_, C_HEADS, C_HEAD_DIM, C_HEAD_DIM), F32)
    _, o = lax.scan(step, init, (to_chunks(qf), to_chunks(k), to_chunks(v), to_chunks(log_f)))
    o = o.transpose(1, 0, 3, 2, 4).reshape(B_, S_, C_HEADS, C_HEAD_DIM)
    o = rms_norm(o, o_gain)
    return o.reshape(B_, S_, C_WIDTH).astype(q.dtype)


def nsa(q, k_cmp, v_cmp, k_slc, v_slc, k_win, v_win, gate_logits, qn, kn_cmp, kn_slc, kn_win,
        pe_k, pe_v, w1k, w2k, w1v, w2v, pos):
    B_, S_, _ = q.shape
    Hkv = D_KV_HEADS
    G = D_HEADS // D_KV_HEADS
    scale = HEAD_DIM ** -0.5
    q = rope(rms_norm(q.reshape(B_, S_, D_HEADS, HEAD_DIM), qn), pos).reshape(B_, S_, Hkv, G, HEAD_DIM)
    t_pos = jnp.arange(S_)

    n_cmp = (S_ - CMP_LEN) // CMP_STRIDE + 1
    cmp_start = jnp.arange(n_cmp) * CMP_STRIDE
    blk_idx = cmp_start[:, None] + jnp.arange(CMP_LEN)[None, :]

    def compress(t, pe, w1, w2):
        tb = t.reshape(B_, S_, Hkv, HEAD_DIM)[:, blk_idx] + pe[None, None, :, None, :]
        flat = tb.transpose(0, 1, 3, 2, 4).reshape(B_, n_cmp, Hkv, CMP_LEN * HEAD_DIM)
        return jax.nn.silu(flat @ w1) @ w2

    cmp_end = cmp_start + CMP_LEN - 1
    kc = rope(rms_norm(compress(k_cmp, pe_k, w1k, w2k), kn_cmp), cmp_end)
    vc = compress(v_cmp, pe_v, w1v, w2v)
    s_c = jnp.einsum('bskgd,bnkd->bkgsn', q, kc).astype(F32) * scale
    mask_c = cmp_end[None, :] <= t_pos[:, None]
    p_c = jax.nn.softmax(jnp.where(mask_c, s_c, NEG_INF), axis=-1)
    p_c = jnp.where(jnp.any(mask_c, axis=-1)[:, None], p_c, 0.0)
    o_cmp = jnp.einsum('bkgsn,bnkd->bskgd', p_c.astype(vc.dtype), vc)

    n_sel = S_ // SEL_LEN
    sel_start = jnp.arange(n_sel) * SEL_LEN
    overlap = ((cmp_start[:, None] < sel_start[None, :] + SEL_LEN) &
               (cmp_start[:, None] + CMP_LEN > sel_start[None, :])).astype(F32)
    imp = jnp.einsum('bkgsn,nj->bksj', p_c, overlap)
    cur = t_pos // SEL_LEN
    jj = jnp.arange(n_sel)
    forced = (jj[None, :] == 0) | (jj[None, :] == cur[:, None])
    valid = jj[None, :] <= cur[:, None]
    score = jnp.where(forced, POS_INF, jnp.where(valid, imp, NEG_INF))
    k_top = min(SEL_TOPK, n_sel)
    _, sel_idx = lax.top_k(score, k_top)
    ks = rope(rms_norm(k_slc.reshape(B_, S_, Hkv, HEAD_DIM), kn_slc), pos)
    ksb = ks.reshape(B_, n_sel, SEL_LEN, Hkv, HEAD_DIM).transpose(0, 3, 1, 2, 4)
    vsb = v_slc.reshape(B_, n_sel, SEL_LEN, Hkv, HEAD_DIM).transpose(0, 3, 1, 2, 4)
    bi = jnp.arange(B_)[:, None, None, None]
    hi = jnp.arange(Hkv)[None, :, None, None]

    def sel_block(j):
        start = j * SEL_Q_BLOCK
        qb = lax.dynamic_slice_in_dim(q, start, SEL_Q_BLOCK, axis=1)
        idx = lax.dynamic_slice_in_dim(sel_idx, start, SEL_Q_BLOCK, axis=2)
        kg = ksb[bi, hi, idx]
        vg = vsb[bi, hi, idx]
        s = jnp.einsum('bqkgd,bkqnld->bkgqnl', qb, kg).astype(F32) * scale
        tq = start + jnp.arange(SEL_Q_BLOCK)
        key_pos = idx[..., None] * SEL_LEN + jnp.arange(SEL_LEN)
        mask = (key_pos <= tq[None, None, :, None, None])[:, :, None]
        s = jnp.where(mask, s, NEG_INF)
        p = jax.nn.softmax(s.reshape(B_, Hkv, G, SEL_Q_BLOCK, k_top * SEL_LEN), axis=-1).reshape(s.shape)
        return jnp.einsum('bkgqnl,bkqnld->bqkgd', p.astype(vg.dtype), vg)

    o_sel = lax.map(sel_block, jnp.arange(S_ // SEL_Q_BLOCK))
    o_sel = jnp.moveaxis(o_sel, 0, 1).reshape(B_, S_, Hkv, G, HEAD_DIM)

    kw = rope(rms_norm(k_win.reshape(B_, S_, Hkv, HEAD_DIM), kn_win), pos)
    o_win = banded_attention(q, kw, v_win.reshape(B_, S_, Hkv, HEAD_DIM), D_WINDOW)

    g = jax.nn.sigmoid(gate_logits).reshape(B_, S_, Hkv, G, D_BRANCHES, 1)
    o = g[..., 0, :] * o_cmp + g[..., 1, :] * o_sel + g[..., 2, :] * o_win
    return o.reshape(B_, S_, D_WIDTH)


def even_layer(h, mem, g, mem_g, w_mem_kv, m_qn, m_kn, w_in, w_out, a_qn, a_kn, a_sinks,
               conv_w, conv_b, w_r, b_r, w_i, b_i, lam, pos):
    xn = rms_norm(h, g)
    z = jnp.einsum('bsd,de->bse', xn, w_in)
    qa, ka, va, ga, xb, gb, qm, gm = split_cols(z, EVEN_SPLITS)
    oa = swa_sink_attention(qa, ka, va, a_qn, a_kn, a_sinks, pos) * jax.nn.silu(ga)
    ob = rglru(xb, conv_w, conv_b, w_r, b_r, w_i, b_i, lam) * jax.nn.silu(gb)
    om = memory_cross_attention(qm, rms_norm(mem, mem_g), w_mem_kv, m_qn, m_kn) * jax.nn.silu(gm)
    return h + jnp.einsum('bse,ed->bsd', jnp.concatenate([oa, ob, om], axis=-1), w_out)


def odd_layer(h, mem, g, mem_g, w_mem_kv, m_qn, m_kn, w_in, w_out, lb, c_og,
              d_qn, d_kn_cmp, d_kn_slc, d_kn_win, pe_k, pe_v, w1k, w2k, w1v, w2v, pos):
    xn = rms_norm(h, g)
    z = jnp.einsum('bsd,de->bse', xn, w_in)
    (qc, fc, ic, gc, qd, kcd, vcd, ksd, vsd, kwd, vwd, gate_d, gd, qm, gm) = split_cols(z, ODD_SPLITS)
    oc = hgrn2(qc, fc, ic, lb, c_og) * jax.nn.silu(gc)
    od = nsa(qd, kcd, vcd, ksd, vsd, kwd, vwd, gate_d, d_qn, d_kn_cmp, d_kn_slc, d_kn_win,
             pe_k, pe_v, w1k, w2k, w1v, w2v, pos) * jax.nn.silu(gd)
    om = memory_cross_attention(qm, rms_norm(mem, mem_g), w_mem_kv, m_qn, m_kn) * jax.nn.silu(gm)
    return h + jnp.einsum('bse,ed->bsd', jnp.concatenate([oc, od, om], axis=-1), w_out)


def setup_inputs(seed: int = 0) -> dict:
    key = jax.random.key(seed)
    keys = iter(jax.random.split(key, 48))

    def nrm(shape, scale):
        return jax.random.normal(next(keys), shape, F32) * scale

    def gain(shape):
        return 1.0 + nrm(shape, 0.02)

    u = jax.random.uniform(next(keys), (N_EVEN, B_WIDTH), F32, minval=0.9, maxval=0.999)
    s = u ** (1.0 / B_C)
    lam = jnp.log(s) - jnp.log1p(-s)
    return {
        "x": nrm((BATCH, SEQ, D_MODEL), 1.0),
        "mem": nrm((BATCH, N_MEM, D_MODEL), 1.0),
        "norm_g": gain((DEPTH, D_MODEL)),
        "mem_norm_g": gain((DEPTH, D_MODEL)),
        "mem_w_kv": nrm((DEPTH, D_MODEL, 2 * M_WIDTH), D_MODEL ** -0.5),
        "mem_qn": gain((DEPTH, HEAD_DIM)),
        "mem_kn": gain((DEPTH, HEAD_DIM)),
        "ev_w_in": nrm((N_EVEN, D_MODEL, EVEN_IN), D_MODEL ** -0.5),
        "ev_w_out": nrm((N_EVEN, EVEN_MIX, D_MODEL), EVEN_MIX ** -0.5),
        "a_qn": gain((N_EVEN, HEAD_DIM)),
        "a_kn": gain((N_EVEN, HEAD_DIM)),
        "a_sinks": nrm((N_EVEN, A_HEADS), 0.5),
        "b_conv_w": nrm((N_EVEN, B_CONV, B_WIDTH), B_CONV ** -0.5),
        "b_conv_b": nrm((N_EVEN, B_WIDTH), 0.01),
        "b_w_r": nrm((N_EVEN, B_BLOCKS, B_BLOCK_DIM, B_BLOCK_DIM), B_BLOCK_DIM ** -0.5),
        "b_b_r": nrm((N_EVEN, B_WIDTH), 0.01),
        "b_w_i": nrm((N_EVEN, B_BLOCKS, B_BLOCK_DIM, B_BLOCK_DIM), B_BLOCK_DIM ** -0.5),
        "b_b_i": nrm((N_EVEN, B_WIDTH), 0.01),
        "b_lambda": lam,
        "od_w_in": nrm((N_ODD, D_MODEL, ODD_IN), D_MODEL ** -0.5),
        "od_w_out": nrm((N_ODD, ODD_MIX, D_MODEL), ODD_MIX ** -0.5),
        "c_lb": nrm((DEPTH, C_WIDTH), 0.5),
        "c_onorm": gain((N_ODD, C_HEAD_DIM)),
        "d_qn": gain((N_ODD, HEAD_DIM)),
        "d_kn_cmp": gain((N_ODD, HEAD_DIM)),
        "d_kn_slc": gain((N_ODD, HEAD_DIM)),
        "d_kn_win": gain((N_ODD, HEAD_DIM)),
        "d_pe_k": nrm((N_ODD, CMP_LEN, HEAD_DIM), 0.02),
        "d_pe_v": nrm((N_ODD, CMP_LEN, HEAD_DIM), 0.02),
        "d_w1k": nrm((N_ODD, CMP_LEN * HEAD_DIM, CMP_HIDDEN), (CMP_LEN * HEAD_DIM) ** -0.5),
        "d_w2k": nrm((N_ODD, CMP_HIDDEN, HEAD_DIM), CMP_HIDDEN ** -0.5),
        "d_w1v": nrm((N_ODD, CMP_LEN * HEAD_DIM, CMP_HIDDEN), (CMP_LEN * HEAD_DIM) ** -0.5),
        "d_w2v": nrm((N_ODD, CMP_HIDDEN, HEAD_DIM), CMP_HIDDEN ** -0.5),
    }


def reference(x, mem, norm_g, mem_norm_g, mem_w_kv, mem_qn, mem_kn, ev_w_in, ev_w_out, a_qn, a_kn, a_sinks,
              b_conv_w, b_conv_b, b_w_r, b_b_r, b_w_i, b_b_i, b_lambda, od_w_in, od_w_out, c_lb, c_onorm,
              d_qn, d_kn_cmp, d_kn_slc, d_kn_win, d_pe_k, d_pe_v, d_w1k, d_w2k, d_w1v, d_w2v):
    pos = jnp.arange(x.shape[1])
    lbs = hgrn_lower_bounds(c_lb)
    h = x
    for l in range(DEPTH):
        e = l // 2
        if l % 2 == 0:
            h = even_layer(h, mem, norm_g[l], mem_norm_g[l], mem_w_kv[l], mem_qn[l], mem_kn[l],
                           ev_w_in[e], ev_w_out[e], a_qn[e], a_kn[e], a_sinks[e],
                           b_conv_w[e], b_conv_b[e], b_w_r[e], b_b_r[e], b_w_i[e], b_b_i[e], b_lambda[e], pos)
        else:
            h = odd_layer(h, mem, norm_g[l], mem_norm_g[l], mem_w_kv[l], mem_qn[l], mem_kn[l],
                          od_w_in[e], od_w_out[e], lbs[l], c_onorm[e],
                          d_qn[e], d_kn_cmp[e], d_kn_slc[e], d_kn_win[e], d_pe_k[e], d_pe_v[e],
                          d_w1k[e], d_w2k[e], d_w1v[e], d_w2v[e], pos)
    return h
```

```cpp
#include <hip/hip_runtime.h>
#include <hip/hip_cooperative_groups.h>
#include <cstdio>
#include <cstdint>
namespace cg = cooperative_groups;

#ifndef ONE_LAUNCH
#define ONE_LAUNCH 1
#endif

#define DI __device__ __forceinline__
typedef unsigned short u16;
typedef short bf16x8 __attribute__((ext_vector_type(8)));
typedef short s16x4 __attribute__((ext_vector_type(4)));
typedef float f32x2 __attribute__((ext_vector_type(2)));
typedef float f32x4 __attribute__((ext_vector_type(4)));
typedef float f32x16 __attribute__((ext_vector_type(16)));
typedef unsigned u32x2 __attribute__((ext_vector_type(2)));
typedef unsigned u32x4 __attribute__((ext_vector_type(4)));
typedef __bf16 bf16x2_t __attribute__((ext_vector_type(2)));

DI unsigned pack2(float a, float b) { f32x2 v = {a, b}; bf16x2_t r = __builtin_convertvector(v, bf16x2_t); return __builtin_bit_cast(unsigned, r); }
DI u16 f2bf(float a) { return (u16)(pack2(a, 0.f) & 0xffffu); }
DI float bflo(unsigned w) { return __uint_as_float(w << 16); }
DI float bfhi(unsigned w) { return __uint_as_float(w & 0xffff0000u); }
DI float bf2f(u16 v) { return __uint_as_float(((unsigned)v) << 16); }
#define MFMA16(a, b, c) __builtin_amdgcn_mfma_f32_16x16x32_bf16((a), (b), (c), 0, 0, 0)
#define MFMA32(a, b, c) __builtin_amdgcn_mfma_f32_32x32x16_bf16((a), (b), (c), 0, 0, 0)
DI float rcpf_(float x) { return __builtin_amdgcn_rcpf(x); }
DI float sigmoidf_(float z) { return rcpf_(1.f + __expf(-z)); }
DI float siluf_(float z) { return z * rcpf_(1.f + __expf(-z)); }
DI float ex2(float x) { return __builtin_amdgcn_exp2f(x); }
DI float xor32_max(float x) { auto t = __builtin_amdgcn_permlane32_swap(__float_as_uint(x), __float_as_uint(x), false, false); return fmaxf(__uint_as_float(t[0]), __uint_as_float(t[1])); }
DI float xor32_sum(float x) { auto t = __builtin_amdgcn_permlane32_swap(__float_as_uint(x), __float_as_uint(x), false, false); return __uint_as_float(t[0]) + __uint_as_float(t[1]); }
DI float xor16_sum(float x) { auto t = __builtin_amdgcn_permlane16_swap(__float_as_uint(x), __float_as_uint(x), false, false); return __uint_as_float(t[0]) + __uint_as_float(t[1]); }
template <int CTRL> DI float dpp_(float x) { return __builtin_bit_cast(float, __builtin_amdgcn_mov_dpp(__builtin_bit_cast(int, x), CTRL, 0xf, 0xf, true)); }
DI float quad_sum(float x) { x += dpp_<0xB1>(x); x += dpp_<0x4E>(x); return x; }
DI int tid_() { int t = threadIdx.x; asm volatile("" : "+v"(t)); return t; }
#define CFENCE asm volatile("" ::: "memory")
#define LBAR() do { asm volatile("s_waitcnt lgkmcnt(0)" ::: "memory"); __builtin_amdgcn_s_barrier(); asm volatile("" ::: "memory"); } while (0)

constexpr int NTHR = 512;
constexpr int TOK = 65536, SEQ = 2048, NBATCH = 32, DM = 1024;
constexpr int LDZ0 = 2816, LDZ1 = 4608, LDMIX = 1280;
constexpr float EPS = 1e-6f;
constexpr float SC_LOG2 = 0.125f * 1.4426950408889634f;
constexpr float LOG2E = 1.4426950408889634f;

constexpr size_t OFF_WT0 = 0;
constexpr size_t OFF_WT1 = OFF_WT0 + (size_t)2816 * 1024 * 2;
constexpr size_t OFF_WO0 = OFF_WT1 + (size_t)4608 * 1024 * 2;
constexpr size_t OFF_WO1 = OFF_WO0 + (size_t)1024 * 1280 * 2;
constexpr size_t OFF_WM = OFF_WO1 + (size_t)1024 * 1280 * 2;
constexpr size_t OFF_W1K = OFF_WM + (size_t)2 * 512 * 1024 * 2;
constexpr size_t OFF_W1V = OFF_W1K + (size_t)256 * 2048 * 2;
constexpr size_t OFF_COS = OFF_W1V + (size_t)256 * 2048 * 2;
constexpr size_t OFF_SIN = OFF_COS + (size_t)2048 * 32 * 4;
constexpr size_t OFF_RS0 = OFF_SIN + (size_t)2048 * 32 * 4;
constexpr size_t OFF_RS1 = OFF_RS0 + (size_t)TOK * 4;
constexpr size_t OFF_RSM = OFF_RS1 + (size_t)TOK * 4;
constexpr size_t OFF_BIAS = OFF_RSM + (size_t)8192 * 4;
constexpr size_t OFF_CTR = OFF_BIAS + 1024;
constexpr size_t OFF_BAR = OFF_CTR + 512;
constexpr size_t OFF_KC = OFF_CTR + 1024;
constexpr size_t OFF_VC = OFF_KC + (size_t)32 * 128 * 128 * 2;
constexpr size_t OFF_MKV = OFF_VC + (size_t)32 * 128 * 128 * 2;
constexpr size_t OFF_MEMB = OFF_MKV + (size_t)2 * 8192 * 512 * 2;
constexpr size_t OFF_XB = OFF_MEMB + (size_t)8192 * 1024 * 2;
constexpr size_t OFF_MIX = OFF_XB + (size_t)TOK * 1024 * 2;
constexpr size_t OFF_Z = OFF_MIX + (size_t)TOK * 1280 * 2;
constexpr size_t OFF_RSP = OFF_Z + (size_t)TOK * 4608 * 2;
constexpr size_t WS_END = OFF_RSP + (size_t)4 * TOK * 4;

struct Params { const float* in[33]; float* out; unsigned char* ws; int ph_lo, ph_hi; };

constexpr int LDS_BYTES = 155776;
constexpr int LDS_TR = 131072, LDS_RED = 147456;
constexpr int GP = 72;
constexpr int GP2 = 136;

struct ALPlain { const u16* A; int lda; static constexpr int dummy = 0; int kstride;
    DI const u16* rowptr(int row) const { return A + (size_t)row * lda; } };
struct ALCmp { const u16* Zc; int kstride;
    DI const u16* rowptr(int row) const { return Zc; } };

template <class Epi, bool CMP>
DI void gemm_unit(unsigned char* lds, const u16* Abase, int lda, int kstrideA, const u16* Bt, int ldb, int nk, int pm, int pn, Epi& epi) {
    const int tid = tid_(), wid = tid >> 6, lane = tid & 63, fr = lane & 15, fq = lane >> 4;
    const int wm = wid >> 2, wn = wid & 3;
    u16* As = (u16*)lds; u16* Bs = As + 2 * 256 * GP;
    const int lrow = tid >> 3, lc8 = (tid & 7) * 8;
    const u16* ap0; const u16* bp0 = Bt + (size_t)(pn * 256 + lrow) * ldb + lc8;
    const size_t bstep = (size_t)64 * ldb;
    const int atok0 = 16 * (lrow >> 1);
    if (CMP) ap0 = Abase + (size_t)(pm * SEQ) * lda + 64 * (lrow & 1) + lc8;
    else ap0 = Abase + (size_t)(pm * 256 + lrow) * lda + lc8;
    const size_t astep = (size_t)64 * lda;
    f32x4 acc[8][4];
#pragma unroll
    for (int a = 0; a < 8; ++a)
#pragma unroll
        for (int b = 0; b < 4; ++b) acc[a][b] = (f32x4){0.f, 0.f, 0.f, 0.f};
    u32x4 ra[4], rb[4];
#pragma unroll
    for (int i = 0; i < 4; ++i) {
        if (CMP) { int t = atok0 + 512 * i; t = t > SEQ - 1 ? SEQ - 1 : t; ra[i] = *(const u32x4*)(ap0 + (size_t)t * lda); }
        else ra[i] = *(const u32x4*)(ap0 + i * astep);
        rb[i] = *(const u32x4*)(bp0 + i * bstep);
    }
    __syncthreads();
#pragma unroll
    for (int i = 0; i < 4; ++i) { *(u32x4*)(As + (lrow + 64 * i) * GP + lc8) = ra[i]; *(u32x4*)(Bs + (lrow + 64 * i) * GP + lc8) = rb[i]; }
    __syncthreads();
    for (int kt = 0; kt < nk; ++kt) {
        const int buf = kt & 1;
        if (kt + 1 < nk) {
#pragma unroll
            for (int i = 0; i < 4; ++i) {
                if (CMP) { int t = atok0 + 512 * i + kt + 1; t = t > SEQ - 1 ? SEQ - 1 : t; ra[i] = *(const u32x4*)(ap0 + (size_t)t * lda); }
                else ra[i] = *(const u32x4*)(ap0 + i * astep + (size_t)(kt + 1) * kstrideA);
                rb[i] = *(const u32x4*)(bp0 + i * bstep + (size_t)(kt + 1) * 64);
            }
        }
        const u16* Ab = As + buf * 256 * GP + (128 * wm + fr) * GP + 8 * fq;
        const u16* Bb = Bs + buf * 256 * GP + (64 * wn + fr) * GP + 8 * fq;
#pragma unroll
        for (int ks = 0; ks < 2; ++ks) {
            bf16x8 bfr[4];
#pragma unroll
            for (int ni = 0; ni < 4; ++ni) bfr[ni] = *(const bf16x8*)(Bb + 16 * ni * GP + 32 * ks);
#pragma unroll
            for (int mi = 0; mi < 8; ++mi) {
                const bf16x8 afr = *(const bf16x8*)(Ab + 16 * mi * GP + 32 * ks);
#pragma unroll
                for (int ni = 0; ni < 4; ++ni) acc[mi][ni] = MFMA16(bfr[ni], afr, acc[mi][ni]);
            }
        }
        if (kt + 1 < nk) {
            u16* Aw = As + (buf ^ 1) * 256 * GP; u16* Bw = Bs + (buf ^ 1) * 256 * GP;
#pragma unroll
            for (int i = 0; i < 4; ++i) { *(u32x4*)(Aw + (lrow + 64 * i) * GP + lc8) = ra[i]; *(u32x4*)(Bw + (lrow + 64 * i) * GP + lc8) = rb[i]; }
        }
        LBAR();
    }
    epi(acc, pm * 256 + 128 * wm, pn * 256 + 64 * wn, lane, lds);
}


namespace pg8 {
#define PG8_LAS __attribute__((address_space(3)))
constexpr int BM = 256, BK = 64, HALF = 128, HTB = HALF * BK * 2, STAGE_BYTES = 8 * HTB;
DI int lds_byte(int r, int c) { const int st = (r >> 4) * 2 + (c >> 5), rr = r & 15, cc = c & 31, ob = rr * 64 + cc * 2; return st * 1024 + (ob ^ (((ob >> 9) & 1) << 5)); }
DI void stage_rc(int b, int& R, int& C) { const int st = b / 1024, sb = b % 1024, swz = sb ^ (((sb >> 9) & 1) << 5); R = (st >> 1) * 16 + swz / 64; C = (st & 1) * 32 + (swz % 64) / 2; }
struct Unit { int pm, pn; };
struct Gemm { const u16* A; const u16* Bt; int K; };

template <class Epi, class Sched, bool ALIGN_EPI>
DI void gemm_phase(PG8_LAS unsigned char* lds, const Gemm g, const Sched& S, Epi& E) {
    const int tid = tid_(), wid = __builtin_amdgcn_readfirstlane(tid >> 6), lane = tid & 63, wr = wid >> 2, wc = wid & 3, fr = lane & 15, fq = lane >> 4;
    const int K = g.K, nt = K / BK;
    unsigned voffA[2];
#pragma unroll
    for (int i = 0; i < 2; ++i) { int R, C; stage_rc(tid * 16 + i * 8192, R, C); voffA[i] = (unsigned)(R * K + C) * 2u; }
    const size_t kstep = (size_t)(BK * 2);
    const size_t hstep = (size_t)HALF * K * 2;
    const size_t tstep = 2 * hstep;
    const unsigned ldsw = (unsigned)wid * 1024u;
    const int aoff = lds_byte(wr * 64 + fr, fq * 8), boff = lds_byte(wc * 32 + fr, fq * 8);
#define PG8_SA(b, h) (((b) * 2 + (h)) * HTB)
#define PG8_SB(b, h) ((4 + (b) * 2 + (h)) * HTB)
#define PG8_STAGE(bufoff, gbase) do { _Pragma("unroll") for (int _i = 0; _i < 2; ++_i) \
        __builtin_amdgcn_global_load_lds((const unsigned*)((const char*)(gbase) + voffA[_i]), (PG8_LAS unsigned*)(lds + (bufoff) + ldsw + _i * 8192), 16, 0, 0); } while (0)
#define PG8_LDA(dst, b, h) do { _Pragma("unroll") for (int m = 0; m < 4; ++m) _Pragma("unroll") for (int k = 0; k < 2; ++k) dst[m][k] = *(const PG8_LAS bf16x8*)(lds + PG8_SA(b, h) + aoff + m * 2048 + k * 1024); } while (0)
#define PG8_LDB(dst, b, h) do { _Pragma("unroll") for (int n = 0; n < 2; ++n) _Pragma("unroll") for (int k = 0; k < 2; ++k) dst[n][k] = *(const PG8_LAS bf16x8*)(lds + PG8_SB(b, h) + boff + n * 2048 + k * 1024); } while (0)
#define PG8_MMA(ai, bj, At, Bt) do { __builtin_amdgcn_s_setprio(1); _Pragma("unroll") for (int m = 0; m < 4; ++m) _Pragma("unroll") for (int n = 0; n < 2; ++n) _Pragma("unroll") for (int k = 0; k < 2; ++k) \
        acc[ai][bj][m][n] = __builtin_amdgcn_mfma_f32_16x16x32_bf16(Bt[n][k], At[m][k], acc[ai][bj][m][n], 0, 0, 0); __builtin_amdgcn_s_setprio(0); } while (0)
#define PG8_WAIT_V(n) asm volatile("s_waitcnt vmcnt(" #n ")" ::: "memory")
#define PG8_WAIT_L(n) asm volatile("s_waitcnt lgkmcnt(" #n ")" ::: "memory")
#define PG8_BAR __builtin_amdgcn_s_barrier()
#define PG8_SCHED __builtin_amdgcn_sched_barrier(0)
    Unit cur, nxt; int ui = 0;
    if (!S.next(0, cur)) return;
    f32x4 acc[2][2][4][2];
#pragma unroll
    for (int a = 0; a < 2; ++a)
#pragma unroll
        for (int b = 0; b < 2; ++b)
#pragma unroll
            for (int m = 0; m < 4; ++m)
#pragma unroll
                for (int n = 0; n < 2; ++n) acc[a][b][m][n] = (f32x4){0.f, 0.f, 0.f, 0.f};
    bf16x8 At[4][2], B0[2][2], B1[2][2];
    const char* cA = (const char*)g.A + (size_t)cur.pm * tstep; const char* cB = (const char*)g.Bt + (size_t)cur.pn * tstep;
    E.pre(cur, wr, fr);
    PG8_STAGE(PG8_SB(0, 0), cB); PG8_STAGE(PG8_SB(0, 1), cB + hstep); PG8_STAGE(PG8_SA(0, 0), cA); PG8_STAGE(PG8_SA(0, 1), cA + hstep);
    if (wr == 1) PG8_BAR;
    PG8_WAIT_V(2); PG8_BAR;
    PG8_STAGE(PG8_SB(1, 0), cB + kstep); PG8_STAGE(PG8_SA(1, 0), cA + kstep); PG8_STAGE(PG8_SB(1, 1), cB + hstep + kstep);
    PG8_WAIT_V(6); PG8_BAR;
    for (;;) {
        const bool has_next = S.next(ui + 1, nxt);
        const char* nA = has_next ? (const char*)g.A + (size_t)nxt.pm * tstep : cA; const char* nB = has_next ? (const char*)g.Bt + (size_t)nxt.pn * tstep : cB;
        for (int t = 0; t < nt; t += 2) {
            const bool last = (t == nt - 2);
            const char* a1 = cA + (size_t)(t + 1) * kstep;
            const char* a2 = last ? nA : cA + (size_t)(t + 2) * kstep; const char* b2 = last ? nB : cB + (size_t)(t + 2) * kstep;
            const char* a3 = a2 + kstep; const char* b3 = b2 + kstep;
            PG8_LDB(B0, 0, 0); PG8_LDB(B1, 0, 1); PG8_SCHED; PG8_LDA(At, 0, 0); PG8_STAGE(PG8_SA(1, 1), a1 + hstep);
            PG8_WAIT_V(8); PG8_WAIT_L(0); PG8_BAR; PG8_MMA(0, 0, At, B0); PG8_MMA(0, 1, At, B1); PG8_BAR; PG8_SCHED;
            PG8_LDA(At, 0, 1); PG8_STAGE(PG8_SB(0, 0), b2); PG8_STAGE(PG8_SB(0, 1), b2 + hstep); PG8_STAGE(PG8_SA(0, 0), a2);
            PG8_WAIT_V(8); PG8_WAIT_L(0); PG8_BAR; PG8_MMA(1, 0, At, B0); PG8_MMA(1, 1, At, B1); PG8_BAR; PG8_SCHED;
            PG8_LDB(B0, 1, 0); PG8_LDB(B1, 1, 1); PG8_SCHED; PG8_LDA(At, 1, 0); PG8_STAGE(PG8_SA(0, 1), a2 + hstep);
            PG8_WAIT_V(8); PG8_WAIT_L(0); PG8_BAR; PG8_MMA(0, 0, At, B0); PG8_MMA(0, 1, At, B1); PG8_BAR; PG8_SCHED;
            PG8_LDA(At, 1, 1); PG8_STAGE(PG8_SB(1, 0), b3); PG8_STAGE(PG8_SB(1, 1), b3 + hstep); PG8_STAGE(PG8_SA(1, 0), a3);
            PG8_WAIT_V(8); PG8_WAIT_L(0); PG8_BAR; PG8_MMA(1, 0, At, B0); PG8_MMA(1, 1, At, B1); PG8_BAR; PG8_SCHED;
        }
        if constexpr (ALIGN_EPI) { if (wr == 0) PG8_BAR; }
        E(acc, cur, wr, wc, fr, fq);
        if (!has_next) break;
#pragma unroll
        for (int a = 0; a < 2; ++a)
#pragma unroll
            for (int b = 0; b < 2; ++b)
#pragma unroll
                for (int m = 0; m < 4; ++m)
#pragma unroll
                    for (int n = 0; n < 2; ++n) acc[a][b][m][n] = (f32x4){0.f, 0.f, 0.f, 0.f};
        cur = nxt; cA = nA; cB = nB; ++ui;
        E.pre(cur, wr, fr);
        if constexpr (ALIGN_EPI) { if (wr == 1) PG8_BAR; }
    }
    PG8_WAIT_V(0);
    if constexpr (!ALIGN_EPI) { if (wr == 0) PG8_BAR; }
    PG8_BAR;
#undef PG8_SA
#undef PG8_SB
#undef PG8_STAGE
#undef PG8_LDA
#undef PG8_LDB
#undef PG8_MMA
#undef PG8_WAIT_V
#undef PG8_WAIT_L
#undef PG8_BAR
#undef PG8_SCHED
}
struct SchedIn { int NT, per, slot, xcd;
    DI bool next(int i, Unit& u) const { const int U = slot + i * per; if (U >= 32 * NT) return false; const int g = U / (8 * NT), r = U - g * 8 * NT; u.pm = xcd * 32 + 8 * g + (r & 7); u.pn = r >> 3; return true; } };
struct SchedOut { int pm;
    DI bool next(int i, Unit& u) const { if (i >= 4) return false; u.pm = pm; u.pn = i; return true; } };
struct SchedOutX { int per, slot, xcd;
    DI bool next(int i, Unit& u) const { const int U = slot + i * per; if (U >= 128) return false; u.pm = xcd * 32 + 8 * (U >> 5) + (U & 7); u.pn = (U & 31) >> 3; return true; } };
struct SchedOne { int pm, pn; bool on;
    DI bool next(int i, Unit& u) const { if (i > 0 || !on) return false; u.pm = pm; u.pn = pn; return true; } };
}


DI void tr_put8(unsigned char* T, int fr, int chunk, int half8, u32x2 w) { *(u32x2*)(T + fr * 128 + ((chunk ^ (fr & 7)) << 4) + half8 * 8) = w; }
DI void tr_put16(unsigned char* T, int fr, int chunk, f32x4 w) { *(f32x4*)(T + fr * 128 + ((chunk ^ (fr & 7)) << 4)) = w; }
DI u32x4 tr_get(const unsigned char* T, int r, int chunk) { return *(const u32x4*)(T + r * 128 + ((chunk ^ (r & 7)) << 4)); }

enum { OP_PLAIN = 0, OP_NORMROPE = 1, OP_NORM = 2, OP_SILU = 3, OP_SIGMOID = 4, OP_LOGF = 5 };

struct EpiZ {
    u16* Z; int ldz; const float* rs; int layer; const Params* p; const float* cs; const float* sn; unsigned char* tr; bool rs4;
    DI void pre(const pg8::Unit&, int, int) {}
    DI void operator()(f32x4 (&acc)[2][2][4][2], const pg8::Unit& u, int wr, int wc, int fr, int fq) {
        asm volatile("" : "+v"(fr), "+v"(fq));
        const int row0 = 256 * u.pm + 64 * wr, col0 = 256 * u.pn + 64 * wc, grp = col0 >> 6;
        int op = OP_PLAIN; const float* gain = nullptr;
        if (layer == 0) {
            if (grp < 8) { op = OP_NORMROPE; gain = p->in[9]; }
            else if (grp < 10) { op = OP_NORMROPE; gain = p->in[10]; }
            else if (grp < 12) op = OP_PLAIN;
            else if (grp < 20) op = OP_SILU;
            else if (grp < 28) op = OP_PLAIN;
            else if (grp < 36) op = OP_SILU;
            else if (grp < 40) { op = OP_NORM; gain = p->in[5]; }
            else op = OP_SILU;
        } else if (layer == 1) {
            if (grp < 8) op = OP_SILU;
            else if (grp < 16) op = OP_LOGF;
            else if (grp < 24) op = OP_PLAIN;
            else if (grp < 32) op = OP_SILU;
            else if (grp < 40) { op = OP_NORMROPE; gain = p->in[23]; }
            else if (grp < 44) op = OP_PLAIN;
            else if (grp < 46) { op = OP_NORMROPE; gain = p->in[25]; }
            else if (grp < 48) op = OP_PLAIN;
            else if (grp < 50) { op = OP_NORMROPE; gain = p->in[26]; }
            else if (grp < 52) op = OP_PLAIN;
            else if (grp < 60) op = OP_SILU;
            else if (grp < 64) { op = OP_NORM; gain = p->in[5] + 64; }
            else if (grp < 68) op = OP_SILU;
            else if (grp < 69) op = OP_SIGMOID;
            else op = OP_PLAIN;
        } else {
            if (grp < 4) { op = OP_NORM; gain = p->in[6] + 64 * (layer - 2); }
            else op = OP_PLAIN;
        }
        f32x4 gn[4];
        if (op == OP_NORMROPE || op == OP_NORM) {
#pragma unroll
            for (int ni = 0; ni < 4; ++ni) gn[ni] = *(const f32x4*)(gain + 16 * ni + 4 * fq);
        } else if (op == OP_LOGF) {
            const float* lbp = p->in[21]; const int ch0 = (grp - 8) * 64;
#pragma unroll
            for (int ni = 0; ni < 4; ++ni) {
                const f32x4 p0 = *(const f32x4*)(lbp + ch0 + 16 * ni + 4 * fq), p1 = *(const f32x4*)(lbp + 512 + ch0 + 16 * ni + 4 * fq);
#pragma unroll
                for (int r = 0; r < 4; ++r) gn[ni][r] = 1.f / (1.f + expf(p0[r] - p1[r]));
            }
        }
        float rsv[8];
#pragma unroll
        for (int mi = 0; mi < 8; ++mi) {
            const float* rp = rs + row0 + 128 * (mi >> 2) + 16 * (mi & 3) + fr;
            rsv[mi] = rs4 ? rsqrtf(((rp[0] + rp[TOK]) + (rp[2 * TOK] + rp[3 * TOK])) * (1.f / 1024.f) + EPS) : rp[0];
        }
        f32x4 invf[2];
        if (op == OP_NORMROPE) {
#pragma unroll
            for (int ni = 0; ni < 2; ++ni)
#pragma unroll
                for (int r = 0; r < 4; ++r) invf[ni][r] = exp2f(-(float)(16 * ni + 4 * fq + r) * (13.287712379549449f / 32.f)) * 0.15915494309189535f;
        }
#pragma unroll
        for (int mi = 0; mi < 8; ++mi) {
            const int row = row0 + 128 * (mi >> 2) + 16 * (mi & 3) + fr;
            const float s = rsv[mi];
            f32x4 v[4];
#pragma unroll
            for (int ni = 0; ni < 4; ++ni) v[ni] = acc[mi >> 2][ni >> 1][mi & 3][ni & 1] * s;
            if (op == OP_NORMROPE || op == OP_NORM) {
                float ss = 0.f;
#pragma unroll
                for (int ni = 0; ni < 4; ++ni) ss += v[ni][0] * v[ni][0] + v[ni][1] * v[ni][1] + v[ni][2] * v[ni][2] + v[ni][3] * v[ni][3];
                ss = xor32_sum(xor16_sum(ss));
                const float inv = rsqrtf(ss * (1.f / 64.f) + EPS);
#pragma unroll
                for (int ni = 0; ni < 4; ++ni) v[ni] = v[ni] * inv * gn[ni];
                if (op == OP_NORMROPE) {
#pragma unroll
                    for (int ni = 0; ni < 2; ++ni) {
                        const float tf = (float)(row & (SEQ - 1));
                        f32x4 c, sv;
#pragma unroll
                        for (int r = 0; r < 4; ++r) { const float fx = __builtin_amdgcn_fractf(tf * invf[ni][r]); c[r] = __builtin_amdgcn_cosf(fx); sv[r] = __builtin_amdgcn_sinf(fx); }
                        const f32x4 x1 = v[ni], x2 = v[ni + 2];
                        v[ni] = x1 * c - x2 * sv; v[ni + 2] = x2 * c + x1 * sv;
                    }
                }
            } else if (op == OP_SILU) {
#pragma unroll
                for (int ni = 0; ni < 4; ++ni)
#pragma unroll
                    for (int r = 0; r < 4; ++r) v[ni][r] = siluf_(v[ni][r]);
            } else if (op == OP_SIGMOID) {
#pragma unroll
                for (int ni = 0; ni < 4; ++ni)
#pragma unroll
                    for (int r = 0; r < 4; ++r) v[ni][r] = sigmoidf_(v[ni][r]);
            } else if (op == OP_LOGF) {
#pragma unroll
                for (int ni = 0; ni < 4; ++ni)
#pragma unroll
                    for (int r = 0; r < 4; ++r) { const float lb = gn[ni][r]; v[ni][r] = __logf(lb + (1.f - lb) * sigmoidf_(v[ni][r])); }
            }
#pragma unroll
            for (int ni = 0; ni < 4; ++ni) { u32x2 w; w.x = pack2(v[ni][0], v[ni][1]); w.y = pack2(v[ni][2], v[ni][3]); tr_put8(tr, fr, 2 * ni + (fq >> 1), fq & 1, w); }
            {
                const int lane = fr + 16 * fq, c8 = lane & 7;
                const int rb = row0 + 128 * (mi >> 2) + 16 * (mi & 3);
#pragma unroll
                for (int k = 0; k < 2; ++k) { const int r = (lane >> 3) + 8 * k; __builtin_nontemporal_store(tr_get(tr, r, c8), (u32x4*)(Z + (size_t)(rb + r) * ldz + col0 + 8 * c8)); }
            }
            CFENCE;
        }
    }
};

struct EpiOut0 {
    const float* x; float* out; u16* xb; float* red; unsigned char* tr; float* rsp;
    int par, ppm, ppn;
    DI void pre(const pg8::Unit&, int, int) {}
    DI void flush(int wr, int wc, int fr, int fq) {
        if (ppm >= 0 && wc == 0 && fq == 0) {
            const float* rd = red + (par ^ 1) * 1024;
#pragma unroll
            for (int mi = 0; mi < 8; ++mi) {
                const int r = 64 * wr + 128 * (mi >> 2) + 16 * (mi & 3) + fr;
                rsp[(size_t)ppn * TOK + 256 * ppm + r] = (rd[r] + rd[256 + r]) + (rd[512 + r] + rd[768 + r]);
            }
        }
    }
    DI void operator()(f32x4 (&acc)[2][2][4][2], const pg8::Unit& u, int wr, int wc, int fr, int fq) {
        asm volatile("" : "+v"(fr), "+v"(fq));
        const int row0 = 256 * u.pm + 64 * wr, col0 = 256 * u.pn + 64 * wc;
        const int lane = fr + 16 * fq, c8 = lane & 7, lr = lane >> 3;
        f32x4 xr[2][2];
#pragma unroll
        for (int k = 0; k < 2; ++k) xr[0][k] = __builtin_nontemporal_load((const f32x4*)(x + (size_t)(row0 + lr + 8 * k) * DM + col0 + 4 * c8));
        flush(wr, wc, fr, fq);
        float* rw = red + par * 1024 + wc * 256 + 64 * wr;
        float ss = 0.f; u32x2 wq[2][2];
#pragma unroll
        for (int st = 0; st < 16; ++st) {
            const int mi = st >> 1, hh = st & 1;
            const int rl = 128 * (mi >> 2) + 16 * (mi & 3) + fr;
            if (st < 15) {
                const int mn = (st + 1) >> 1, hn = (st + 1) & 1;
                const int rbn = row0 + 128 * (mn >> 2) + 16 * (mn & 3);
#pragma unroll
                for (int k = 0; k < 2; ++k) xr[(st + 1) & 1][k] = __builtin_nontemporal_load((const f32x4*)(x + (size_t)(rbn + lr + 8 * k) * DM + col0 + 32 * hn + 4 * c8));
            }
#pragma unroll
            for (int k = 0; k < 2; ++k) tr_put16(tr, lr + 8 * k, c8, xr[st & 1][k]);
#pragma unroll
            for (int n = 0; n < 2; ++n) {
                const f32x4 xv = *(const f32x4*)(tr + fr * 128 + (((4 * n + fq) ^ (fr & 7)) << 4));
                const f32x4 v = acc[mi >> 2][hh][mi & 3][n] + xv;
                wq[hh][n].x = pack2(v[0], v[1]); wq[hh][n].y = pack2(v[2], v[3]);
                ss += v[0] * v[0] + v[1] * v[1] + v[2] * v[2] + v[3] * v[3];
            }
            if (hh) {
                ss = xor32_sum(xor16_sum(ss));
                if (fq == 0) rw[rl] = ss;
                ss = 0.f;
#pragma unroll
                for (int h2 = 0; h2 < 2; ++h2)
#pragma unroll
                    for (int n = 0; n < 2; ++n) tr_put8(tr, fr, 2 * (2 * h2 + n) + (fq >> 1), fq & 1, wq[h2][n]);
                const int rb = row0 + 128 * (mi >> 2) + 16 * (mi & 3);
#pragma unroll
                for (int k = 0; k < 2; ++k) { const int r = lr + 8 * k; *(u32x4*)(xb + (size_t)(rb + r) * DM + col0 + 8 * c8) = tr_get(tr, r, c8); }
            }
            CFENCE;
        }
        ppm = u.pm; ppn = u.pn; par ^= 1;
    }
};
struct EpiOut1 {
    float* out; const u16* xb; unsigned char* tr;
    DI void pre(const pg8::Unit&, int, int) {}
    DI void operator()(f32x4 (&acc)[2][2][4][2], const pg8::Unit& u, int wr, int wc, int fr, int fq) const {
        asm volatile("" : "+v"(fr), "+v"(fq));
        const int row0 = 256 * u.pm + 64 * wr, col0 = 256 * u.pn + 64 * wc;
        const int lane = fr + 16 * fq, c8 = lane & 7, lr = lane >> 3;
        u32x4 hb[2][2];
#pragma unroll
        for (int k = 0; k < 2; ++k) hb[0][k] = *(const u32x4*)(xb + (size_t)(row0 + lr + 8 * k) * DM + col0 + 8 * c8);
#pragma unroll
        for (int mi = 0; mi < 8; ++mi) {
            const int rb = row0 + 128 * (mi >> 2) + 16 * (mi & 3);
            if (mi < 7) {
                const int rbn = row0 + 128 * ((mi + 1) >> 2) + 16 * ((mi + 1) & 3);
#pragma unroll
                for (int k = 0; k < 2; ++k) hb[(mi + 1) & 1][k] = *(const u32x4*)(xb + (size_t)(rbn + lr + 8 * k) * DM + col0 + 8 * c8);
            }
#pragma unroll
            for (int k = 0; k < 2; ++k) { const int r = lr + 8 * k; *(u32x4*)(tr + r * 128 + ((c8 ^ (r & 7)) << 4)) = hb[mi & 1][k]; }
            u32x2 hw[4];
#pragma unroll
            for (int ni = 0; ni < 4; ++ni) hw[ni] = *(const u32x2*)(tr + fr * 128 + (((2 * ni + (fq >> 1)) ^ (fr & 7)) << 4) + 8 * (fq & 1));
#pragma unroll
            for (int hh = 0; hh < 2; ++hh) {
#pragma unroll
                for (int n = 0; n < 2; ++n) {
                    const u32x2 w = hw[2 * hh + n];
                    const f32x4 a = acc[mi >> 2][hh][mi & 3][n];
                    tr_put16(tr, fr, 4 * n + fq, (f32x4){bflo(w.x) + a[0], bfhi(w.x) + a[1], bflo(w.y) + a[2], bfhi(w.y) + a[3]});
                }
#pragma unroll
                for (int k = 0; k < 2; ++k) { const int r = lr + 8 * k; __builtin_nontemporal_store(tr_get(tr, r, c8), (u32x4*)(out + (size_t)(rb + r) * DM + col0 + 32 * hh + 4 * c8)); }
            }
            CFENCE;
        }
    }
};

struct EpiCmp {
    const float* bias; const float* w2; const float* gain; u16* dst; bool isk; const float* cs; const float* sn;
    DI void operator()(f32x4 (&acc)[8][4], int row0, int col0, int lane, unsigned char* lds) const {
        const int fr = lane & 15, fq = lane >> 4, tid = tid_();
        float* Hs = (float*)lds;
        if (col0 < 128) {
            const int lrow0 = row0 & 255;
#pragma unroll
            for (int mi = 0; mi < 8; ++mi)
#pragma unroll
                for (int ni = 0; ni < 4; ++ni)
#pragma unroll
                    for (int r = 0; r < 4; ++r) { const int c = col0 + 16 * ni + 4 * fq + r; Hs[(lrow0 + 16 * mi + fr) * 129 + c] = siluf_(acc[mi][ni][r] + bias[c]); }
        }
        __syncthreads();
        const int lrow = tid >> 1, half = tid & 1;
        const int row = (row0 & ~255) + lrow;
        float o[32];
#pragma unroll
        for (int c = 0; c < 32; ++c) o[c] = 0.f;
        for (int j = 0; j < 128; ++j) {
            const float hv = Hs[lrow * 129 + j];
            const float* wr = w2 + j * 64 + 32 * half;
#pragma unroll
            for (int c4 = 0; c4 < 8; ++c4) { const f32x4 w = *(const f32x4*)(wr + 4 * c4); o[4 * c4] += hv * w[0]; o[4 * c4 + 1] += hv * w[1]; o[4 * c4 + 2] += hv * w[2]; o[4 * c4 + 3] += hv * w[3]; }
        }
        if (isk) {
            float ss = 0.f;
#pragma unroll
            for (int c = 0; c < 32; ++c) ss += o[c] * o[c];
            ss += __shfl_xor(ss, 1);
            const float inv = rsqrtf(ss * (1.f / 64.f) + EPS);
            const int n = (row >> 1) & 127; int t = 16 * n + 31; t = t > SEQ - 1 ? SEQ - 1 : t;
#pragma unroll
            for (int c = 0; c < 32; ++c) {
                const float mine = o[c] * inv * gain[32 * half + c];
                const float other = __shfl_xor(mine, 1);
                const float cv = cs[t * 32 + c], sv = sn[t * 32 + c];
                o[c] = half == 0 ? (mine * cv - other * sv) : (mine * cv + other * sv);
            }
        }
        u16* dp = dst + (size_t)row * 64 + 32 * half;
#pragma unroll
        for (int c8 = 0; c8 < 4; ++c8) { u32x4 w; w.x = pack2(o[8 * c8], o[8 * c8 + 1]); w.y = pack2(o[8 * c8 + 2], o[8 * c8 + 3]); w.z = pack2(o[8 * c8 + 4], o[8 * c8 + 5]); w.w = pack2(o[8 * c8 + 6], o[8 * c8 + 7]); *(u32x4*)(dp + 8 * c8) = w; }
        __syncthreads();
    }
};

DI int srccol(int mode, int n) {
    if (mode == 0) return n;
    if (mode == 1) { if (n < 3328) return n; if (n < 4352) return n + 24; if (n < 4376) return n - 1024; return -1; }
    return n < 128 ? n : -1;
}
DI int physrow(int n) { const int w = n & 255; return (n & ~255) + 128 * ((w >> 5) & 1) + 32 * (w >> 6) + (w & 31); }
DI void tconv(unsigned char* lds, const float* src, int ldsrc, int K, int N, u16* dst, const float* gain, int mode, int first, int stride) {
    float* tl = (float*)lds;
    const int tid = tid_(), nkt = K / 64, ntile = nkt * (N / 64);
    for (int tile = first; tile < ntile; tile += stride) {
        const int k0 = (tile % nkt) * 64, n0 = (tile / nkt) * 64;
#pragma unroll
        for (int i = 0; i < 8; ++i) {
            const int k = (tid >> 6) + 8 * i, n = tid & 63; const int sc = srccol(mode, n0 + n);
            float v = 0.f; if (sc >= 0) { v = src[(size_t)(k0 + k) * ldsrc + sc]; if (gain) v *= gain[k0 + k]; }
            tl[k * 65 + n] = v;
        }
        __syncthreads();
#pragma unroll
        for (int i = 0; i < 8; ++i) { const int n = (tid >> 6) + 8 * i, k = tid & 63; const int pr = mode == 2 ? n0 + n : physrow(n0 + n); dst[(size_t)pr * K + k0 + k] = f2bf(tl[k * 65 + n]); }
        __syncthreads();
    }
}
DI void phase_prep(const Params& p, unsigned char* lds) {
    unsigned char* ws = p.ws;
    const int tid = tid_(), wid = tid >> 6, lane = tid & 63;
    if (blockIdx.x == 0 && tid < 256) ((unsigned*)(ws + OFF_CTR))[tid] = 0u;
    for (int rb = blockIdx.x; rb < (TOK + 8192) / 16; rb += gridDim.x) {
        f32x4 v[2][4]; const float* src[2]; u16* dst[2]; float* rsd[2];
#pragma unroll
        for (int h = 0; h < 2; ++h) {
            const int r = rb * 16 + 2 * wid + h;
            if (r < TOK) { src[h] = p.in[0] + (size_t)r * DM; dst[h] = (u16*)(ws + OFF_XB) + (size_t)r * DM; rsd[h] = (float*)(ws + OFF_RS0) + r; }
            else { const int rr = r - TOK; src[h] = p.in[1] + (size_t)rr * DM; dst[h] = (u16*)(ws + OFF_MEMB) + (size_t)rr * DM; rsd[h] = (float*)(ws + OFF_RSM) + rr; }
#pragma unroll
            for (int i = 0; i < 4; ++i) v[h][i] = __builtin_nontemporal_load((const f32x4*)(src[h] + 4 * (lane + 64 * i)));
        }
#pragma unroll
        for (int h = 0; h < 2; ++h) {
            float ss = 0.f;
#pragma unroll
            for (int i = 0; i < 4; ++i) ss += v[h][i][0] * v[h][i][0] + v[h][i][1] * v[h][i][1] + v[h][i][2] * v[h][i][2] + v[h][i][3] * v[h][i][3];
#pragma unroll
            for (int o = 1; o < 64; o <<= 1) ss += __shfl_xor(ss, o);
            if (lane == 0) *rsd[h] = rsqrtf(ss * (1.f / 1024.f) + EPS);
#pragma unroll
            for (int i = 0; i < 4; ++i) { u32x2 w; w.x = pack2(v[h][i][0], v[h][i][1]); w.y = pack2(v[h][i][2], v[h][i][3]); *(u32x2*)(dst[h] + 4 * (lane + 64 * i)) = w; }
        }
    }
    const int b0 = blockIdx.x, gs = gridDim.x;
    tconv(lds, p.in[7], 2816, 1024, 2816, (u16*)(ws + OFF_WT0), p.in[2], 0, b0, gs);
    tconv(lds, p.in[8], 1024, 1280, 1024, (u16*)(ws + OFF_WO0), nullptr, 0, b0, gs);
    tconv(lds, p.in[4], 512, 1024, 512, (u16*)(ws + OFF_WM), p.in[3], 0, b0, gs);
    tconv(lds, p.in[4] + (size_t)1024 * 512, 512, 1024, 512, (u16*)(ws + OFF_WM) + (size_t)512 * 1024, p.in[3] + 1024, 0, b0, gs);
    for (int idx = blockIdx.x * NTHR + tid; idx < 2048 * 32; idx += gridDim.x * NTHR) {
        const int t = idx >> 5, i = idx & 31;
        const float inv = exp2f(-(float)i * (13.287712379549449f / 32.f));
        const double rev = (double)t * (double)inv * 0.15915494309189535;
        const float fr = (float)(rev - floor(rev));
        ((float*)(ws + OFF_COS))[idx] = __builtin_amdgcn_cosf(fr);
        ((float*)(ws + OFF_SIN))[idx] = __builtin_amdgcn_sinf(fr);
    }
}
DI void prep_layer1(const Params& p, unsigned char* lds, int first, int stride) {
    unsigned char* ws = p.ws;
    const int tid = tid_(), wid = tid >> 6, lane = tid & 63;
    __syncthreads();
    tconv(lds, p.in[19], 4376, 1024, 4608, (u16*)(ws + OFF_WT1), p.in[2] + 1024, 1, first, stride);
    tconv(lds, p.in[20], 1024, 1280, 1024, (u16*)(ws + OFF_WO1), nullptr, 0, first, stride);
    tconv(lds, p.in[29], 128, 2048, 256, (u16*)(ws + OFF_W1K), nullptr, 2, first, stride);
    tconv(lds, p.in[31], 128, 2048, 256, (u16*)(ws + OFF_W1V), nullptr, 2, first, stride);
    for (int task = first; task < 32; task += stride) {
        const int kv = task >> 4, j = (task & 15) * 8 + wid;
        const float* pe = kv ? p.in[28] : p.in[27]; const float* w1 = kv ? p.in[31] : p.in[29];
        float s = 0.f;
        for (int i = lane; i < 2048; i += 64) s += pe[i] * w1[(size_t)i * 128 + j];
#pragma unroll
        for (int o = 1; o < 64; o <<= 1) s += __shfl_xor(s, o);
        if (lane == 0) ((float*)(ws + OFF_BIAS))[kv * 128 + j] = s;
    }
}

struct TileSrc { const u16* k; const u16* v; int kstride, vstride; };
DI void tile_load(const TileSrc& s, u32x4& rk, u32x4& rv, int tid) {
    rk = *(const u32x4*)(s.k + (size_t)(tid >> 3) * s.kstride + (tid & 7) * 8);
    rv = *(const u32x4*)(s.v + (size_t)(tid >> 3) * s.vstride + (tid & 7) * 8);
}
DI void tile_store(u16* Kt, u16* Vt, const u32x4& rk, const u32x4& rv, int tid) {
    *(u32x4*)(Kt + (tid >> 3) * GP + (tid & 7) * 8) = rk;
    *(u32x4*)(Vt + (tid >> 3) * GP + (tid & 7) * 8) = rv;
}
typedef __attribute__((address_space(3))) s16x4 lds_s16x4;
DI s16x4 tr_read(const u16* p) { return __builtin_amdgcn_ds_read_tr16_b64_v4i16((lds_s16x4*)p); }
struct AttnAcc { f32x16 o[2]; float m, l; };
DI void attn_reset(AttnAcc& a) {
#pragma unroll
    for (int i = 0; i < 16; ++i) { a.o[0][i] = 0.f; a.o[1][i] = 0.f; }
    a.m = -1e30f; a.l = 0.f;
}
template <int MODE, class MaskF>
DI void attn_compute(const u16* Kt, const u16* Vt, const bf16x8 (&q)[4], AttnAcc& st, int lane, bool rowon, MaskF valid) {
    const int r32 = lane & 31, h = lane >> 5;
    f32x16 X[2];
#pragma unroll
    for (int kt2 = 0; kt2 < 2; ++kt2) {
#pragma unroll
        for (int i = 0; i < 16; ++i) X[kt2][i] = 0.f;
#pragma unroll
        for (int s = 0; s < 4; ++s) { const bf16x8 kf = *(const bf16x8*)(Kt + (32 * kt2 + r32) * GP + 16 * s + 8 * h); X[kt2] = MFMA32(kf, q[s], X[kt2]); }
    }
    float mx = -1e30f;
    if (MODE == 0) {
#pragma unroll
        for (int kt2 = 0; kt2 < 2; ++kt2)
#pragma unroll
            for (int reg = 0; reg < 16; ++reg) {
                const int kl = 32 * kt2 + (reg & 3) + 8 * (reg >> 2) + 4 * h;
                float t = X[kt2][reg]; t = valid(kl) ? t : -1e30f; X[kt2][reg] = t; mx = fmaxf(mx, t);
            }
    } else {
#pragma unroll
        for (int kt2 = 0; kt2 < 2; ++kt2)
#pragma unroll
            for (int reg = 0; reg < 16; ++reg) mx = fmaxf(mx, X[kt2][reg]);
        if (MODE == 2) mx = rowon ? mx : -1e30f;
    }
    mx = xor32_max(mx);
    const float mn = fmaxf(st.m, mx > -1e29f ? mx * SC_LOG2 : -1e30f);
    const float alpha = ex2(st.m - mn);
    float rsum = 0.f;
#pragma unroll
    for (int kt2 = 0; kt2 < 2; ++kt2)
#pragma unroll
        for (int reg = 0; reg < 16; ++reg) {
            const float t = X[kt2][reg]; float pv = ex2(fmaf(t, SC_LOG2, -mn));
            if (MODE == 0) pv = t > -1e29f ? pv : 0.f;
            if (MODE == 2) pv = rowon ? pv : 0.f;
            X[kt2][reg] = pv; rsum += pv;
        }
    rsum = xor32_sum(rsum);
    st.l = st.l * alpha + rsum; st.m = mn;
#pragma unroll
    for (int i = 0; i < 16; ++i) { st.o[0][i] *= alpha; st.o[1][i] *= alpha; }
    bf16x8 pf[2][2];
#pragma unroll
    for (int kt2 = 0; kt2 < 2; ++kt2)
#pragma unroll
        for (int s = 0; s < 2; ++s) {
            u32x4 w; w.x = pack2(X[kt2][8 * s], X[kt2][8 * s + 1]); w.y = pack2(X[kt2][8 * s + 2], X[kt2][8 * s + 3]);
            w.z = pack2(X[kt2][8 * s + 4], X[kt2][8 * s + 5]); w.w = pack2(X[kt2][8 * s + 6], X[kt2][8 * s + 7]);
            pf[kt2][s] = __builtin_bit_cast(bf16x8, w);
        }
#pragma unroll
    for (int nt = 0; nt < 2; ++nt)
#pragma unroll
        for (int kt2 = 0; kt2 < 2; ++kt2)
#pragma unroll
            for (int s = 0; s < 2; ++s) {
                const u16* vp = Vt + (32 * kt2 + 16 * s + 4 * h + ((lane & 15) >> 2)) * GP + 32 * nt + 16 * ((lane >> 4) & 1) + 4 * (lane & 3);
                const s16x4 lo = tr_read(vp), hi = tr_read(vp + 8 * GP);
                const bf16x8 vf = __builtin_shufflevector(lo, hi, 0, 1, 2, 3, 4, 5, 6, 7);
                st.o[nt] = MFMA32(vf, pf[kt2][s], st.o[nt]);
            }
}
constexpr int LDS_WT = 98304;
DI unsigned char* wtile(unsigned char* lds, int wid) { return lds + LDS_WT + 4096 * wid; }
template <class RowF> DI void rows_to_tile(unsigned char* T, int lane, RowF rowptr) {
#pragma unroll
    for (int k = 0; k < 4; ++k) { const int rr = (lane >> 3) + 8 * k, c = lane & 7; const u32x4 v = *(const u32x4*)(rowptr(rr) + 8 * c); *(u32x4*)(T + rr * 128 + ((c ^ (rr & 7)) << 4)) = v; }
}
template <class RowF> DI void tile_to_rows(const unsigned char* T, int lane, RowF rowptr) {
#pragma unroll
    for (int k = 0; k < 4; ++k) { const int rr = (lane >> 3) + 8 * k, c = lane & 7; *(u32x4*)(rowptr(rr) + 8 * c) = *(const u32x4*)(T + rr * 128 + ((c ^ (rr & 7)) << 4)); }
}
template <class RowF, class GateF> DI void load_q(unsigned char* T, bf16x8 (&q)[4], int lane, RowF qrow, GateF gaterow) {
    u32x4 qv[4], gv[4];
#pragma unroll
    for (int k = 0; k < 4; ++k) { const int rr = (lane >> 3) + 8 * k, c = lane & 7; qv[k] = *(const u32x4*)(qrow(rr) + 8 * c); }
#pragma unroll
    for (int k = 0; k < 4; ++k) { const int rr = (lane >> 3) + 8 * k, c = lane & 7; gv[k] = *(const u32x4*)(gaterow(rr) + 8 * c); }
#pragma unroll
    for (int k = 0; k < 4; ++k) { const int rr = (lane >> 3) + 8 * k, c = lane & 7; *(u32x4*)(T + rr * 128 + ((c ^ (rr & 7)) << 4)) = qv[k]; }
    const int r32 = lane & 31, h = lane >> 5;
#pragma unroll
    for (int s = 0; s < 4; ++s) q[s] = *(const bf16x8*)(T + r32 * 128 + (((2 * s + h) ^ (r32 & 7)) << 4));
#pragma unroll
    for (int k = 0; k < 4; ++k) { const int rr = (lane >> 3) + 8 * k, c = lane & 7; *(u32x4*)(T + rr * 128 + ((c ^ (rr & 7)) << 4)) = gv[k]; }
}
template <class DstF> DI void store_gated(unsigned char* T, const f32x16 (&o)[2], float mul, int lane, DstF dstrow) {
    const int r32 = lane & 31, h = lane >> 5;
#pragma unroll
    for (int nt = 0; nt < 2; ++nt)
#pragma unroll
        for (int qd = 0; qd < 4; ++qd) {
            unsigned char* a = T + r32 * 128 + (((4 * nt + qd) ^ (r32 & 7)) << 4) + 8 * h;
            const u32x2 g = *(const u32x2*)a;
            u32x2 w; w.x = pack2(o[nt][4 * qd] * mul * bflo(g.x), o[nt][4 * qd + 1] * mul * bfhi(g.x)); w.y = pack2(o[nt][4 * qd + 2] * mul * bflo(g.y), o[nt][4 * qd + 3] * mul * bfhi(g.y));
            *(u32x2*)a = w;
        }
    tile_to_rows(T, lane, dstrow);
}

template <class SrcF, class CompF>
DI void tile_loop(unsigned char* lds, int n, int tid, SrcF src, CompF comp) {
    u16* K0 = (u16*)lds; u16* V0 = K0 + 64 * GP; u16* K1 = (u16*)(lds + 18432); u16* V1 = K1 + 64 * GP;
    u32x4 rk[2], rv[2];
    { const TileSrc s0 = src(0); tile_load(s0, rk[0], rv[0], tid); }
    { const TileSrc s1 = src(n > 1 ? 1 : 0); tile_load(s1, rk[1], rv[1], tid); }
    LBAR();
    tile_store(K0, V0, rk[0], rv[0], tid);
    LBAR();
    for (int i2 = 0; i2 < n; i2 += 2) {
#pragma unroll
        for (int j = 0; j < 2; ++j) {
            const int i = i2 + j;
            { const int nx = i + 2 < n ? i + 2 : n - 1; const TileSrc s2 = src(nx); tile_load(s2, rk[j], rv[j], tid); }
            __builtin_amdgcn_sched_barrier(0);
            if (i < n) comp(i, j ? K1 : K0, j ? V1 : V0);
            __builtin_amdgcn_sched_barrier(0);
            tile_store(j ? K0 : K1, j ? V0 : V1, rk[j ^ 1], rv[j ^ 1], tid);
            LBAR();
        }
    }
}

DI void item_swa(const Params& p, unsigned char* lds, int item) {
    const u16* Z = (const u16*)(p.ws + OFF_Z); u16* MIX = (u16*)(p.ws + OFF_MIX);
    const int tid = tid_(), wid = tid >> 6, lane = tid & 63, r32 = lane & 31;
    const int qt = item & 31, kvh = (item >> 5) & 1, b = item >> 6;
    const int tok = 64 * qt + 8 * wid + (r32 >> 2), head = 4 * kvh + (r32 & 3);
    const size_t row = (size_t)b * SEQ + tok;
    unsigned char* WT = wtile(lds, wid);
    const size_t rowb = (size_t)b * SEQ + 64 * qt + 8 * wid;
    const int kt0 = qt >= 2 ? qt - 2 : 0, nt = qt - kt0 + 1;
    u32x4 rk[3], rv[3];
#pragma unroll
    for (int t = 0; t < 3; ++t) { const int kt = kt0 + (t < nt ? t : nt - 1); const u16* zb = Z + ((size_t)b * SEQ + 64 * kt) * LDZ0; const TileSrc ts{zb + 512 + 64 * kvh, zb + 640 + 64 * kvh, LDZ0, LDZ0}; tile_load(ts, rk[t], rv[t], tid); }
    bf16x8 q[4]; load_q(WT, q, lane, [&](int rr) { return Z + (rowb + (rr >> 2)) * LDZ0 + 64 * (4 * kvh + (rr & 3)); },
                        [&](int rr) { return Z + (rowb + (rr >> 2)) * LDZ0 + 768 + 64 * (4 * kvh + (rr & 3)); });
    AttnAcc st; attn_reset(st);
    LBAR();
#pragma unroll
    for (int t = 0; t < 3; ++t) tile_store((u16*)(lds + 18432 * t), (u16*)(lds + 18432 * t) + 64 * GP, rk[t], rv[t], tid);
    LBAR();
#pragma unroll 1
    for (int t = 0; t < nt; ++t) {
        const u16* Kt = (const u16*)(lds + 18432 * t); const u16* Vt = Kt + 64 * GP;
        const int kt = kt0 + t, base = 64 * kt;
        if (kt == qt - 1) attn_compute<1>(Kt, Vt, q, st, lane, true, [&](int) { return true; });
        else attn_compute<0>(Kt, Vt, q, st, lane, true, [&](int kl) { const int s = base + kl; return s <= tok && s > tok - 128; });
    }
    const float sink = p.in[11][head];
    const float denom = st.l + ex2(sink * LOG2E - st.m);
    store_gated(WT, st.o, 1.f / denom, lane, [&](int rr) { return MIX + (rowb + (rr >> 2)) * LDMIX + 64 * (4 * kvh + (rr & 3)); });
}

DI void item_mem(const Params& p, unsigned char* lds, int item, int layer) {
    const u16* Z = (const u16*)(p.ws + OFF_Z); u16* MIX = (u16*)(p.ws + OFF_MIX);
    const u16* MKV = (const u16*)(p.ws + OFF_MKV) + (size_t)layer * 8192 * 512;
    const int ldz = layer ? LDZ1 : LDZ0, qcol = layer ? 3840 : 2304, gcol = layer ? 4096 : 2560;
    const int tid = tid_(), wid = tid >> 6, lane = tid & 63, r32 = lane & 31;
    const int tile = item & 7, head = (item >> 3) & 3, b = item >> 5;
    const int tok = 256 * tile + 32 * wid + r32;
    const size_t row = (size_t)b * SEQ + tok;
    unsigned char* WT = wtile(lds, wid);
    const size_t rowb = (size_t)b * SEQ + 256 * tile + 32 * wid;
    const u16* kb = MKV + (size_t)(b * 256) * 512 + 64 * head;
    u32x4 rk[4], rv[4];
#pragma unroll
    for (int t = 0; t < 4; ++t) { const TileSrc ts{kb + (size_t)(64 * t) * 512, kb + (size_t)(64 * t) * 512 + 256, 512, 512}; tile_load(ts, rk[t], rv[t], tid); }
    bf16x8 q[4]; load_q(WT, q, lane, [&](int rr) { return Z + (rowb + rr) * ldz + qcol + 64 * head; }, [&](int rr) { return Z + (rowb + rr) * ldz + gcol + 64 * head; });
    AttnAcc st; attn_reset(st);
    LBAR();
#pragma unroll
    for (int t = 0; t < 4; ++t) tile_store((u16*)(lds + 18432 * t), (u16*)(lds + 18432 * t) + 64 * GP, rk[t], rv[t], tid);
    LBAR();
#pragma unroll 1
    for (int t = 0; t < 4; ++t) { const u16* kt = (const u16*)(lds + 18432 * t); attn_compute<1>(kt, kt + 64 * GP, q, st, lane, true, [&](int) { return true; }); }
    store_gated(WT, st.o, 1.f / st.l, lane, [&](int rr) { return MIX + (rowb + rr) * LDMIX + 1024 + 64 * head; });
}

DI void item_nsa(const Params& p, unsigned char* lds, int item) {
    const u16* Z = (const u16*)(p.ws + OFF_Z); u16* MIX = (u16*)(p.ws + OFF_MIX);
    const u16* KC = (const u16*)(p.ws + OFF_KC); const u16* VC = (const u16*)(p.ws + OFF_VC);
    u16* Kc = (u16*)(lds + 36864); u16* Vtc = (u16*)(lds + 55296);
    float* pc4 = (float*)(lds + 73728); float* pl = (float*)(lds + 82432);
    unsigned* selm = (unsigned*)(lds + 91136); unsigned* umw = (unsigned*)(lds + 91392);
    const int tid = tid_(), wid = tid >> 6, lane = tid & 63, r32 = lane & 31, h = lane >> 5;
    const int qt = 31 - (item >> 6), kvh = item & 1, b = (item >> 1) & 31;
    const int ttl = 8 * wid + (r32 >> 2);
    const int tok = 64 * qt + ttl, head = 4 * kvh + (r32 & 3);
    const size_t row = (size_t)b * SEQ + tok;
    const u16* zrow = Z + row * LDZ1;
    unsigned char* WT = wtile(lds, wid);
    const size_t rowb = (size_t)b * SEQ + 64 * qt + 8 * wid;
    bf16x8 q[4]; load_q(WT, q, lane, [&](int rr) { return Z + (rowb + (rr >> 2)) * LDZ1 + 2048 + 64 * (4 * kvh + (rr & 3)); },
                        [&](int rr) { return Z + (rowb + (rr >> 2)) * LDZ1 + 3328 + 64 * (4 * kvh + (rr & 3)); });
    float gcmp, gsel, gwin;
    { const u16* gp = zrow + 4352 + 3 * head; gcmp = bf2f(gp[0]); gsel = bf2f(gp[1]); gwin = bf2f(gp[2]); }
    f32x16 osum[2];
    {
        const u16* kcb = KC + ((size_t)(b * 128) * 2 + kvh) * 64; const u16* vcb = VC + ((size_t)(b * 128) * 2 + kvh) * 64;
        u32x4 ck[2], cv[2];
#pragma unroll
        for (int i = 0; i < 2; ++i) {
            ck[i] = *(const u32x4*)(kcb + (size_t)((tid >> 3) + 64 * i) * 128 + (tid & 7) * 8);
            cv[i] = *(const u32x4*)(vcb + (size_t)((tid >> 3) + 64 * i) * 128 + (tid & 7) * 8);
        }
        __syncthreads();
#pragma unroll
        for (int i = 0; i < 2; ++i) {
            const int key = (tid >> 3) + 64 * i;
            *(u32x4*)(Kc + key * GP + (tid & 7) * 8) = ck[i];
            *(u32x4*)(Vtc + key * GP + (tid & 7) * 8) = cv[i];
        }
    }
    __syncthreads();
    {
        f32x16 X[4];
#pragma unroll
        for (int k4 = 0; k4 < 4; ++k4) {
#pragma unroll
            for (int i = 0; i < 16; ++i) X[k4][i] = 0.f;
#pragma unroll
            for (int s = 0; s < 4; ++s) { const bf16x8 kf = *(const bf16x8*)(Kc + (32 * k4 + r32) * GP + 16 * s + 8 * h); X[k4] = MFMA32(kf, q[s], X[k4]); }
        }
        const int nmax = tok >= 31 ? ((tok - 31) >> 4) : -1;
        float mx = -1e30f;
#pragma unroll
        for (int k4 = 0; k4 < 4; ++k4)
#pragma unroll
            for (int reg = 0; reg < 16; ++reg) { const int n = 32 * k4 + (reg & 3) + 8 * (reg >> 2) + 4 * h; float t = X[k4][reg] * SC_LOG2; t = n <= nmax ? t : -1e30f; X[k4][reg] = t; mx = fmaxf(mx, t); }
        mx = xor32_max(mx);
        float rsum = 0.f;
#pragma unroll
        for (int k4 = 0; k4 < 4; ++k4)
#pragma unroll
            for (int reg = 0; reg < 16; ++reg) { const float t = X[k4][reg]; const float pv = t > -1e29f ? ex2(t - mx) : 0.f; X[k4][reg] = pv; rsum += pv; }
        rsum = xor32_sum(rsum);
        const float inv = rsum > 0.f ? 1.f / rsum : 0.f;
#pragma unroll
        for (int k4 = 0; k4 < 4; ++k4)
#pragma unroll
            for (int reg = 0; reg < 16; ++reg) X[k4][reg] *= inv;
#pragma unroll
        for (int k4 = 0; k4 < 4; ++k4)
#pragma unroll
            for (int q4 = 0; q4 < 4; ++q4) {
                float s4 = (X[k4][4 * q4] + X[k4][4 * q4 + 1]) + (X[k4][4 * q4 + 2] + X[k4][4 * q4 + 3]);
                float lt = X[k4][4 * q4 + 3];
                s4 = quad_sum(s4); lt = quad_sum(lt);
                if ((r32 & 3) == 0) { const int j = 8 * k4 + 2 * q4 + h; pc4[ttl * 33 + j] = s4; pl[ttl * 33 + j] = lt; }
            }
        f32x16 o[2];
#pragma unroll
        for (int i = 0; i < 16; ++i) { o[0][i] = 0.f; o[1][i] = 0.f; }
#pragma unroll
        for (int k4 = 0; k4 < 4; ++k4)
#pragma unroll
            for (int s = 0; s < 2; ++s) {
                u32x4 w; w.x = pack2(X[k4][8 * s], X[k4][8 * s + 1]); w.y = pack2(X[k4][8 * s + 2], X[k4][8 * s + 3]);
                w.z = pack2(X[k4][8 * s + 4], X[k4][8 * s + 5]); w.w = pack2(X[k4][8 * s + 6], X[k4][8 * s + 7]);
                const bf16x8 pf = __builtin_bit_cast(bf16x8, w);
#pragma unroll
                for (int nt = 0; nt < 2; ++nt) {
                    const u16* vp = Vtc + (32 * k4 + 16 * s + 4 * h + ((lane & 15) >> 2)) * GP + 32 * nt + 16 * ((lane >> 4) & 1) + 4 * (lane & 3);
                    const s16x4 lo = tr_read(vp), hi = tr_read(vp + 8 * GP);
                    const bf16x8 vf = __builtin_shufflevector(lo, hi, 0, 1, 2, 3, 4, 5, 6, 7);
                    o[nt] = MFMA32(vf, pf, o[nt]);
                }
            }
#pragma unroll
        for (int i = 0; i < 16; ++i) { osum[0][i] = o[0][i] * gcmp; osum[1][i] = o[1][i] * gcmp; }
    }
    __syncthreads();
    if (tid < 64) {
        const int cur = qt;
        unsigned mask = 1u | (1u << cur);
        const int npick = 2;
        if (cur >= 2) {
            int p1 = -1, p2 = -1; float b1 = -1.f, b2 = -1.f;
            for (int j = 1; j < cur; ++j) {
                const float v = pc4[tid * 33 + j] + pl[tid * 33 + j - 1];
                if (v > b1) { b2 = b1; p2 = p1; b1 = v; p1 = j; }
                else if (v > b2) { b2 = v; p2 = j; }
            }
            if (p1 >= 0) mask |= 1u << p1;
            if (p2 >= 0) mask |= 1u << p2;
        }
        selm[tid] = mask;
        unsigned um = mask;
#pragma unroll
        for (int o = 1; o < 64; o <<= 1) um |= (unsigned)__shfl_xor((int)um, o);
        if (tid == 0) umw[0] = um;
    }
    __syncthreads();
    const unsigned sm = selm[ttl];
    unsigned um = umw[0];
    {
        AttnAcc st; attn_reset(st);
        const int ntile = __builtin_popcount(um);
        unsigned rem_src = um, rem_cmp = um; int kt_src = 0;
        tile_loop(lds, ntile, tid,
            [&](int) { if (rem_src) { kt_src = __builtin_ctz(rem_src); rem_src &= rem_src - 1; } const int kt = kt_src; const u16* zb = Z + ((size_t)b * SEQ + 64 * kt) * LDZ1; return TileSrc{zb + 2816 + 64 * kvh, zb + 2944 + 64 * kvh, LDZ1, LDZ1}; },
            [&](int, const u16* Kt, const u16* Vt) {
                const int ktc = __builtin_ctz(rem_cmp); rem_cmp &= rem_cmp - 1;
                const int kt = ktc, base = 64 * kt; const bool on = (sm >> kt) & 1u;
                if (__any(on)) {
                    if (kt < qt) attn_compute<2>(Kt, Vt, q, st, lane, on, [&](int) { return true; });
                    else attn_compute<0>(Kt, Vt, q, st, lane, true, [&](int kl) { return on && (base + kl <= tok); });
                }
            });
        const float mul = gsel / st.l;
#pragma unroll
        for (int i = 0; i < 16; ++i) { osum[0][i] += st.o[0][i] * mul; osum[1][i] += st.o[1][i] * mul; }
    }
    {
        AttnAcc st; attn_reset(st);
        const int kt0 = qt >= 8 ? qt - 8 : 0;
        tile_loop(lds, qt - kt0 + 1, tid,
            [&](int i) { const u16* zb = Z + ((size_t)b * SEQ + 64 * (kt0 + i)) * LDZ1; return TileSrc{zb + 3072 + 64 * kvh, zb + 3200 + 64 * kvh, LDZ1, LDZ1}; },
            [&](int i, const u16* Kt, const u16* Vt) {
                const int kt = kt0 + i, base = 64 * kt;
                if (kt < qt && kt > qt - 8) attn_compute<1>(Kt, Vt, q, st, lane, true, [&](int) { return true; });
                else attn_compute<0>(Kt, Vt, q, st, lane, true, [&](int kl) { const int s = base + kl; return s <= tok && s > tok - 512; });
            });
        const float mul = gwin / st.l;
#pragma unroll
        for (int i = 0; i < 16; ++i) { osum[0][i] += st.o[0][i] * mul; osum[1][i] += st.o[1][i] * mul; }
    }
    store_gated(WT, osum, 1.f, lane, [&](int rr) { return MIX + (rowb + (rr >> 2)) * LDMIX + 512 + 64 * (4 * kvh + (rr & 3)); });
}

DI void item_rglru(const Params& p, unsigned char* lds, int item) {
    const u16* Z = (const u16*)(p.ws + OFF_Z); u16* MIX = (u16*)(p.ws + OFF_MIX);
    float* Xs = (float*)lds;
    float* XC = (float*)(lds + 17152);
    u16* XCb = (u16*)(lds + 34560);
    u16* WrT = (u16*)(lds + 43776); u16* WiT = (u16*)(lds + 52992);
    float* Aa = (float*)(lds + 62208); float* Uu = (float*)(lds + 78592);
    u16* Gs = (u16*)(lds + 94976);
    float* segA = (float*)(lds + 103168); float* segB = (float*)(lds + 105216);
    float* carry = (float*)(lds + 107264);
    const int tid = tid_(), wid = tid >> 6, lane = tid & 63, fr = lane & 15, fq = lane >> 4;
    const int hb = item & 7, b = item >> 3;
    __syncthreads();
    {
        const float* wr = p.in[14] + (size_t)hb * 4096; const float* wi = p.in[16] + (size_t)hb * 4096;
#pragma unroll
        for (int e = 0; e < 8; ++e) { const int idx = tid + 512 * e, i = idx >> 6, j = idx & 63; WrT[j * GP + i] = f2bf(wr[idx]); WiT[j * GP + i] = f2bf(wi[idx]); }
        if (tid < 192) Xs[tid] = 0.f;
        if (tid < 64) carry[tid] = 0.f;
    }
    const int ct = tid >> 3, cc8 = (tid & 7) * 8;
    float cw[4][8], cb[8];
#pragma unroll
    for (int e = 0; e < 8; ++e) {
        cb[e] = p.in[13][64 * hb + cc8 + e];
#pragma unroll
        for (int j = 0; j < 4; ++j) cw[j][e] = p.in[12][j * 512 + 64 * hb + cc8 + e];
    }
    const int jt = wid & 3, tpair = wid >> 2;
    float sp[4], br[4], bi[4];
#pragma unroll
    for (int r = 0; r < 4; ++r) {
        const int c = 64 * hb + 16 * jt + 4 * fq + r;
        const float lam = p.in[18][c];
        sp[r] = log1pf(expf(-lam)); br[r] = p.in[15][c]; bi[r] = p.in[17][c];
    }
    const size_t zrow0 = (size_t)b * SEQ;
    u32x4 rx = *(const u32x4*)(Z + (zrow0 + ct) * LDZ0 + 1280 + 64 * hb + cc8);
    u32x4 rg = *(const u32x4*)(Z + (zrow0 + ct) * LDZ0 + 1792 + 64 * hb + cc8);
    for (int c = 0; c < 32; ++c) {
        {
            float* xr = Xs + (3 + ct) * 64 + cc8;
            *(f32x4*)xr = (f32x4){bflo(rx.x), bfhi(rx.x), bflo(rx.y), bfhi(rx.y)};
            *(f32x4*)(xr + 4) = (f32x4){bflo(rx.z), bfhi(rx.z), bflo(rx.w), bfhi(rx.w)};
            *(u32x4*)(Gs + ct * 64 + cc8) = rg;
        }
        LBAR();
        {
            const int cn = c + 1 < 32 ? c + 1 : 31;
            rx = *(const u32x4*)(Z + (zrow0 + 64 * cn + ct) * LDZ0 + 1280 + 64 * hb + cc8);
            rg = *(const u32x4*)(Z + (zrow0 + 64 * cn + ct) * LDZ0 + 1792 + 64 * hb + cc8);
        }
        __builtin_amdgcn_sched_barrier(0);
        {
            float xc[8];
#pragma unroll
            for (int e = 0; e < 8; ++e) xc[e] = cb[e];
#pragma unroll
            for (int j = 0; j < 4; ++j) {
                const f32x4 a = *(const f32x4*)(Xs + (ct + j) * 64 + cc8), bb = *(const f32x4*)(Xs + (ct + j) * 64 + cc8 + 4);
#pragma unroll
                for (int e = 0; e < 4; ++e) { xc[e] += cw[j][e] * a[e]; xc[4 + e] += cw[j][4 + e] * bb[e]; }
            }
            *(f32x4*)(XC + ct * 68 + cc8) = (f32x4){xc[0], xc[1], xc[2], xc[3]};
            *(f32x4*)(XC + ct * 68 + cc8 + 4) = (f32x4){xc[4], xc[5], xc[6], xc[7]};
            u32x4 w; w.x = pack2(xc[0], xc[1]); w.y = pack2(xc[2], xc[3]); w.z = pack2(xc[4], xc[5]); w.w = pack2(xc[6], xc[7]);
            *(u32x4*)(XCb + ct * GP + cc8) = w;
        }
        LBAR();
        {
#pragma unroll
            for (int ts = 0; ts < 2; ++ts) {
                const int tt = 2 * tpair + ts;
                f32x4 accr = {0.f, 0.f, 0.f, 0.f}, acci = {0.f, 0.f, 0.f, 0.f};
#pragma unroll
                for (int ks = 0; ks < 2; ++ks) {
                    const bf16x8 ar = *(const bf16x8*)(WrT + (16 * jt + fr) * GP + 32 * ks + 8 * fq);
                    const bf16x8 ai = *(const bf16x8*)(WiT + (16 * jt + fr) * GP + 32 * ks + 8 * fq);
                    const bf16x8 bx = *(const bf16x8*)(XCb + (16 * tt + fr) * GP + 32 * ks + 8 * fq);
                    accr = MFMA16(ar, bx, accr); acci = MFMA16(ai, bx, acci);
                }
                const int t = 16 * tt + fr;
                const f32x4 xc4 = *(const f32x4*)(XC + t * 68 + 16 * jt + 4 * fq);
                f32x4 av, uv;
#pragma unroll
                for (int r = 0; r < 4; ++r) {
                    const float rgate = sigmoidf_(accr[r] + br[r]), igate = sigmoidf_(acci[r] + bi[r]);
                    const float la = -8.f * rgate * sp[r];
                    av[r] = __expf(la); uv[r] = __builtin_amdgcn_sqrtf(fmaxf(1.f - __expf(2.f * la), 0.f)) * igate * xc4[r];
                }
                *(f32x4*)(Aa + t * 64 + 16 * jt + 4 * fq) = av; *(f32x4*)(Uu + t * 64 + 16 * jt + 4 * fq) = uv;
            }
            if (tid < 192) Xs[tid] = Xs[64 * 64 + tid];
        }
        LBAR();
        const int ch = tid & 63, seg = tid >> 6;
        float av8[8], uv8[8];
        {
            float A = 1.f, B = 0.f;
#pragma unroll
            for (int i = 0; i < 8; ++i) { av8[i] = Aa[(8 * seg + i) * 64 + ch]; uv8[i] = Uu[(8 * seg + i) * 64 + ch]; B = av8[i] * B + uv8[i]; A *= av8[i]; }
            segA[seg * 64 + ch] = A; segB[seg * 64 + ch] = B;
        }
        LBAR();
        {
            float hst = carry[(c & 1) * 64 + ch];
#pragma unroll
            for (int s = 0; s < 7; ++s) if (s < seg) hst = segA[s * 64 + ch] * hst + segB[s * 64 + ch];
#pragma unroll
            for (int i = 0; i < 8; ++i) {
                hst = av8[i] * hst + uv8[i];
                const int t = 8 * seg + i;
                MIX[(zrow0 + 64 * c + t) * LDMIX + 512 + 64 * hb + ch] = f2bf(hst * bf2f(Gs[t * 64 + ch]));
            }
            if (seg == 7) carry[((c + 1) & 1) * 64 + ch] = hst;
        }
        LBAR();
    }
}

DI void item_hgrn(const Params& p, unsigned char* lds, int item) {
    const u16* __restrict__ Z = (const u16*)(p.ws + OFF_Z); u16* __restrict__ MIX = (u16*)(p.ws + OFF_MIX);
    u16* Qs = (u16*)lds;
    u16* Ks = (u16*)(lds + 17408);
    u16* Vr = (u16*)(lds + 34816);
    u16* KhT = (u16*)(lds + 52224);
    u16* VT = (u16*)(lds + 70656);
    u16* As = (u16*)(lds + 89088);
    u16* ST = (u16*)(lds + 98304);
    float* qsum = (float*)(lds + 133120);
    float* dec = (float*)(lds + 135168);
    float* ssq = (float*)(lds + 135680);
    const int tid = tid_(), wid = tid >> 6, lane = tid & 63, fr = lane & 15, fq = lane >> 4;
    const int head = item & 3, b = item >> 2;
    const int d = tid & 127, qt = tid >> 7;
    const int lt = tid >> 3, lc = (tid & 7) * 16;
    __syncthreads();
    for (int i = tid; i < 128 * GP2 / 2; i += NTHR) ((unsigned*)ST)[i] = 0u;
    f32x4 sacc[8];
#pragma unroll
    for (int v = 0; v < 8; ++v) sacc[v] = (f32x4){0.f, 0.f, 0.f, 0.f};
    float og[4];
#pragma unroll
    for (int r = 0; r < 4; ++r) og[r] = p.in[22][16 * wid + 4 * fq + r];
    const size_t zrow0 = (size_t)b * SEQ;
    const int gcol = 1536 + 128 * head + 16 * wid + 4 * fq;
    u32x4 rq[2], rg[2], rv[2]; u32x2 gn[4];
    {
        const u16* zp = Z + (zrow0 + lt) * LDZ1 + 128 * head + lc;
        rq[0] = *(const u32x4*)zp; rq[1] = *(const u32x4*)(zp + 8);
        rg[0] = *(const u32x4*)(zp + 512); rg[1] = *(const u32x4*)(zp + 520);
        rv[0] = *(const u32x4*)(zp + 1024); rv[1] = *(const u32x4*)(zp + 1032);
#pragma unroll
        for (int tt = 0; tt < 4; ++tt) gn[tt] = *(const u32x2*)(Z + (zrow0 + 16 * tt + fr) * LDZ1 + gcol);
    }
    for (int c = 0; c < 32; ++c) {
        u32x2 gc[4];
        {
            *(u32x4*)(Qs + lt * GP2 + lc) = rq[0]; *(u32x4*)(Qs + lt * GP2 + lc + 8) = rq[1];
            *(u32x4*)(Ks + lt * GP2 + lc) = rg[0]; *(u32x4*)(Ks + lt * GP2 + lc + 8) = rg[1];
            *(u32x4*)(Vr + lt * GP2 + lc) = rv[0]; *(u32x4*)(Vr + lt * GP2 + lc + 8) = rv[1];
#pragma unroll
            for (int tt = 0; tt < 4; ++tt) gc[tt] = gn[tt];
        }
        LBAR();
        {
            const int cn = c + 1 < 32 ? c + 1 : 31;
            const u16* zp = Z + (zrow0 + 64 * cn + lt) * LDZ1 + 128 * head + lc;
            rq[0] = *(const u32x4*)zp; rq[1] = *(const u32x4*)(zp + 8);
            rg[0] = *(const u32x4*)(zp + 512); rg[1] = *(const u32x4*)(zp + 520);
            rv[0] = *(const u32x4*)(zp + 1024); rv[1] = *(const u32x4*)(zp + 1032);
#pragma unroll
            for (int tt = 0; tt < 4; ++tt) gn[tt] = *(const u32x2*)(Z + (zrow0 + 64 * cn + 16 * tt + fr) * LDZ1 + gcol);
        }
        __builtin_amdgcn_sched_barrier(0);
        float bl[16], gv[16];
        {
            float run = 0.f;
#pragma unroll
            for (int i = 0; i < 16; ++i) { gv[i] = bf2f(Ks[(16 * qt + i) * GP2 + d]); run += gv[i]; bl[i] = run; }
            qsum[qt * 128 + d] = run;
        }
        LBAR();
        {
            float off = 0.f, tot = 0.f;
#pragma unroll
            for (int qq = 0; qq < 4; ++qq) { const float s = qsum[qq * 128 + d]; tot += s; if (qq < qt) off += s; }
            unsigned khw[8], vw[8];
#pragma unroll
            for (int i2 = 0; i2 < 8; ++i2) {
                float kh[2], vv[2];
#pragma unroll
                for (int e = 0; e < 2; ++e) {
                    const int i = 2 * i2 + e;
                    const float bb = off + bl[i];
                    const float kk = 1.f - __expf(gv[i]);
                    const float qv = bf2f(Qs[(16 * qt + i) * GP2 + d]);
                    vv[e] = bf2f(Vr[(16 * qt + i) * GP2 + d]);
                    Qs[(16 * qt + i) * GP2 + d] = f2bf(qv * __expf(bb));
                    Ks[(16 * qt + i) * GP2 + d] = f2bf(kk * __expf(fminf(-bb, 80.f)));
                    kh[e] = kk * __expf(tot - bb);
                }
                khw[i2] = pack2(kh[0], kh[1]); vw[i2] = pack2(vv[0], vv[1]);
            }
            *(u32x4*)(KhT + d * GP + 16 * qt) = (u32x4){khw[0], khw[1], khw[2], khw[3]};
            *(u32x4*)(KhT + d * GP + 16 * qt + 8) = (u32x4){khw[4], khw[5], khw[6], khw[7]};
            *(u32x4*)(VT + d * GP + 16 * qt) = (u32x4){vw[0], vw[1], vw[2], vw[3]};
            *(u32x4*)(VT + d * GP + 16 * qt + 8) = (u32x4){vw[4], vw[5], vw[6], vw[7]};
            if (qt == 0) dec[d] = __expf(tot);
        }
        LBAR();
        {
            const int st = wid >> 1;
#pragma unroll
            for (int ts = 0; ts < 2; ++ts) {
                const int tt = 2 * (wid & 1) + ts;
                f32x4 acc = {0.f, 0.f, 0.f, 0.f};
                if (st <= tt) {
#pragma unroll
                    for (int ks = 0; ks < 4; ++ks) {
                        const bf16x8 a = *(const bf16x8*)(Ks + (16 * st + fr) * GP2 + 32 * ks + 8 * fq);
                        const bf16x8 bq = *(const bf16x8*)(Qs + (16 * tt + fr) * GP2 + 32 * ks + 8 * fq);
                        acc = MFMA16(a, bq, acc);
                    }
                }
                const int t = 16 * tt + fr, s0 = 16 * st + 4 * fq;
                float a4[4];
#pragma unroll
                for (int r = 0; r < 4; ++r) a4[r] = (s0 + r <= t) ? acc[r] : 0.f;
                u32x2 w; w.x = pack2(a4[0], a4[1]); w.y = pack2(a4[2], a4[3]);
                *(u32x2*)(As + t * GP + s0) = w;
            }
        }
        LBAR();
        f32x4 oacc[4];
        {
#pragma unroll
            for (int tt = 0; tt < 4; ++tt) oacc[tt] = (f32x4){0.f, 0.f, 0.f, 0.f};
#pragma unroll
            for (int ks = 0; ks < 4; ++ks) {
                const bf16x8 a = *(const bf16x8*)(ST + (16 * wid + fr) * GP2 + 32 * ks + 8 * fq);
#pragma unroll
                for (int tt = 0; tt < 4; ++tt) { const bf16x8 bq = *(const bf16x8*)(Qs + (16 * tt + fr) * GP2 + 32 * ks + 8 * fq); oacc[tt] = MFMA16(a, bq, oacc[tt]); }
            }
#pragma unroll
            for (int ks = 0; ks < 2; ++ks) {
                const bf16x8 a = *(const bf16x8*)(VT + (16 * wid + fr) * GP + 32 * ks + 8 * fq);
#pragma unroll
                for (int tt = 0; tt < 4; ++tt) { const bf16x8 ba = *(const bf16x8*)(As + (16 * tt + fr) * GP + 32 * ks + 8 * fq); oacc[tt] = MFMA16(a, ba, oacc[tt]); }
            }
#pragma unroll
            for (int tt = 0; tt < 4; ++tt) {
                float s = oacc[tt][0] * oacc[tt][0] + oacc[tt][1] * oacc[tt][1] + oacc[tt][2] * oacc[tt][2] + oacc[tt][3] * oacc[tt][3];
                s = xor32_sum(xor16_sum(s));
                if (fq == 0) ssq[wid * 64 + 16 * tt + fr] = s;
            }
        }
        LBAR();
        {
#pragma unroll
            for (int tt = 0; tt < 4; ++tt) {
                const int t = 16 * tt + fr;
                float tot = 0.f;
#pragma unroll
                for (int w = 0; w < 8; ++w) tot += ssq[w * 64 + t];
                const float inv = rsqrtf(tot * (1.f / 128.f) + EPS);
                const size_t row = zrow0 + 64 * c + t;
                const u32x2 g = gc[tt];
                u32x2 w; w.x = pack2(oacc[tt][0] * inv * og[0] * bflo(g.x), oacc[tt][1] * inv * og[1] * bfhi(g.x));
                w.y = pack2(oacc[tt][2] * inv * og[2] * bflo(g.y), oacc[tt][3] * inv * og[3] * bfhi(g.y));
                *(u32x2*)(MIX + row * LDMIX + 128 * head + 16 * wid + 4 * fq) = w;
            }
            const f32x4 d4 = *(const f32x4*)(dec + 16 * wid + 4 * fq);
#pragma unroll
            for (int v = 0; v < 8; ++v) sacc[v] = sacc[v] * d4;
#pragma unroll
            for (int ks = 0; ks < 2; ++ks) {
                const bf16x8 a = *(const bf16x8*)(KhT + (16 * wid + fr) * GP + 32 * ks + 8 * fq);
#pragma unroll
                for (int v = 0; v < 8; ++v) { const bf16x8 bv = *(const bf16x8*)(VT + (16 * v + fr) * GP + 32 * ks + 8 * fq); sacc[v] = MFMA16(a, bv, sacc[v]); }
            }
#pragma unroll
            for (int v = 0; v < 8; ++v) { u32x2 w; w.x = pack2(sacc[v][0], sacc[v][1]); w.y = pack2(sacc[v][2], sacc[v][3]); *(u32x2*)(ST + (16 * v + fr) * GP2 + 16 * wid + 4 * fq) = w; }
        }
        LBAR();
    }
}

DI void phase_inproj(const Params& p, unsigned char* lds, int layer) {
    unsigned char* ws = p.ws;
    PG8_LAS unsigned char* l3 = (PG8_LAS unsigned char*)lds;
    const int NT = layer ? 18 : 11;
    EpiZ e; e.Z = (u16*)(ws + OFF_Z); e.ldz = layer ? LDZ1 : LDZ0; e.rs = (const float*)(ws + (layer ? OFF_RSP : OFF_RS0)); e.rs4 = (layer != 0); e.layer = layer; e.p = &p;
    e.cs = (const float*)(ws + OFF_COS); e.sn = (const float*)(ws + OFF_SIN); e.tr = lds + LDS_TR + 2048 * (tid_() >> 6);
    pg8::Gemm g{(const u16*)(ws + OFF_XB), (const u16*)(ws + (layer ? OFF_WT1 : OFF_WT0)), DM};
    pg8::SchedIn S{NT, (int)(gridDim.x >> 3), (int)(blockIdx.x >> 3), (int)(blockIdx.x & 7)};
    pg8::gemm_phase<EpiZ, pg8::SchedIn, true>(l3, g, S, e);
    if (layer == 0) {
        for (int u = blockIdx.x; u < 128; u += gridDim.x) {
            const int l = u >> 6, pm = (u >> 1) & 31, pn = u & 1;
            EpiZ em; em.Z = (u16*)(ws + OFF_MKV) + (size_t)l * 8192 * 512; em.ldz = 512; em.rs = (const float*)(ws + OFF_RSM); em.layer = 2 + l; em.p = &p; em.cs = e.cs; em.sn = e.sn; em.tr = e.tr; em.rs4 = false;
            pg8::Gemm gm{(const u16*)(ws + OFF_MEMB), (const u16*)(ws + OFF_WM) + (size_t)l * 512 * 1024, DM};
            pg8::SchedOne S1{pm, pn, true};
            pg8::gemm_phase<EpiZ, pg8::SchedOne, false>(l3, gm, S1, em);
        }
        if (gridDim.x > 128) { if (blockIdx.x >= 128) prep_layer1(p, lds, blockIdx.x - 128, gridDim.x - 128); }
        else prep_layer1(p, lds, blockIdx.x, gridDim.x);
    }
}

DI void phase_outproj(const Params& p, unsigned char* lds, int layer) {
    unsigned char* ws = p.ws;
    PG8_LAS unsigned char* l3 = (PG8_LAS unsigned char*)lds;
    pg8::Gemm g{(const u16*)(ws + OFF_MIX), (const u16*)(ws + (layer ? OFF_WO1 : OFF_WO0)), LDMIX};
    const int tid = tid_();
    if (layer == 0) {
        EpiOut0 e; e.x = p.in[0]; e.out = p.out; e.xb = (u16*)(ws + OFF_XB); e.red = (float*)(lds + LDS_RED); e.tr = lds + LDS_TR + 2048 * (tid >> 6);
        e.rsp = (float*)(ws + OFF_RSP); e.par = 0; e.ppm = -1; e.ppn = 0;
        pg8::SchedOutX S{(int)(gridDim.x >> 3), (int)(blockIdx.x >> 3), (int)(blockIdx.x & 7)};
        pg8::gemm_phase<EpiOut0, pg8::SchedOutX, true>(l3, g, S, e);
        __syncthreads();
        { const int lane = tid & 63, wid = tid >> 6; e.flush(wid >> 2, wid & 3, lane & 15, lane >> 4); }
        __syncthreads();
    }
    if (layer == 1) {
        EpiOut1 e; e.out = p.out; e.xb = (const u16*)(ws + OFF_XB); e.tr = lds + LDS_TR + 2048 * (tid >> 6);
        pg8::SchedOutX S{(int)(gridDim.x >> 3), (int)(blockIdx.x >> 3), (int)(blockIdx.x & 7)};
        pg8::gemm_phase<EpiOut1, pg8::SchedOutX, true>(l3, g, S, e);
    }
}

DI void compress_unit(const Params& p, unsigned char* lds, int u) {
    unsigned char* ws = p.ws;
    const int kv = u & 1, pm = u >> 1;
    EpiCmp e; e.bias = (const float*)(ws + OFF_BIAS) + 128 * kv; e.w2 = kv ? p.in[32] : p.in[30]; e.gain = p.in[24]; e.dst = (u16*)(ws + (kv ? OFF_VC : OFF_KC)); e.isk = (kv == 0);
    e.cs = (const float*)(ws + OFF_COS); e.sn = (const float*)(ws + OFF_SIN);
    const u16* Zc = (const u16*)(ws + OFF_Z) + (kv ? 2688 : 2560);
    gemm_unit<EpiCmp, true>(lds, Zc, LDZ1, 0, (const u16*)(ws + (kv ? OFF_W1V : OFF_W1K)), 2048, 32, pm, 0, e);
}

DI void phase_mix0(const Params& p, unsigned char* lds) {
    for (int it = blockIdx.x; it < 256; it += gridDim.x) item_rglru(p, lds, it);
    for (int it = blockIdx.x; it < 2048; it += gridDim.x) item_swa(p, lds, it);
    for (int it = blockIdx.x; it < 1024; it += gridDim.x) item_mem(p, lds, it, 0);
}

__shared__ int s_ticket;
DI void phase_mix1(const Params& p, unsigned char* lds, int ci) {
    unsigned* ctr = (unsigned*)(p.ws + OFF_CTR) + ci;
    bool cmp_ready = false;
    unsigned nxt = 0;
    if (threadIdx.x == 0) nxt = atomicAdd(ctr, 1u);
    for (;;) {
        __syncthreads();
        if (threadIdx.x == 0) { s_ticket = (int)nxt; nxt = atomicAdd(ctr, 1u); }
        __syncthreads();
        const int tk = s_ticket;
        if (tk >= 128 + 64 + 1024 + 2048) break;
        if (tk < 128) item_hgrn(p, lds, tk);
        else if (tk < 192) {
            compress_unit(p, lds, tk - 128);
            __threadfence(); __syncthreads();
            if (threadIdx.x == 0) atomicAdd(ctr + 8, 1u);
        }
        else if (tk < 192 + 1024) item_mem(p, lds, tk - 192, 1);
        else {
            if (!cmp_ready) {
                if (threadIdx.x == 0) { while (__hip_atomic_load(ctr + 8, __ATOMIC_RELAXED, __HIP_MEMORY_SCOPE_AGENT) < 64u) __builtin_amdgcn_s_sleep(8); }
                __syncthreads(); __threadfence(); cmp_ready = true;
            }
            item_nsa(p, lds, tk - 192 - 1024);
        }
    }
}


DI void gbar(unsigned* bar, unsigned k) {
    __syncthreads();
    if (threadIdx.x == 0) {
        __builtin_amdgcn_fence(__ATOMIC_RELEASE, "agent"); asm volatile("s_waitcnt vmcnt(0)" ::: "memory");
        atomicAdd(bar, 1u);
        const unsigned target = k * gridDim.x;
        while (__hip_atomic_load(bar, __ATOMIC_RELAXED, __HIP_MEMORY_SCOPE_AGENT) < target) __builtin_amdgcn_s_sleep(2);
        __builtin_amdgcn_fence(__ATOMIC_ACQUIRE, "agent"); asm volatile("s_waitcnt vmcnt(0)" ::: "memory");
    }
    __syncthreads();
}

constexpr int NPHASE = 8;
__global__ void __launch_bounds__(NTHR) mega(Params p) {
    extern __shared__ __attribute__((aligned(16))) unsigned char lds[];
    cg::grid_group grid = cg::this_grid();
#ifndef PROBE_MASK
#define PROBE_MASK 0
#endif
    unsigned* bar = (unsigned*)(p.ws + OFF_BAR); unsigned nbar = 0;
#define PH(k, call0, call1) if (p.ph_lo <= (k) && (k) < p.ph_hi) { call0; if ((PROBE_MASK >> (k)) & 1) { grid.sync(); call1; } if ((k) + 1 < p.ph_hi) { if ((k) == 0) grid.sync(); else gbar(bar, ++nbar); } }
    PH(0, phase_prep(p, lds), phase_prep(p, lds))
    PH(1, phase_inproj(p, lds, 0), phase_inproj(p, lds, 0))
    PH(2, phase_mix0(p, lds), phase_mix0(p, lds))
    PH(3, phase_outproj(p, lds, 0), phase_outproj(p, lds, 0))
    PH(4, phase_inproj(p, lds, 1), phase_inproj(p, lds, 1))
    PH(6, phase_mix1(p, lds, 0), phase_mix1(p, lds, 1))
    PH(7, phase_outproj(p, lds, 1), phase_outproj(p, lds, 1))
#undef PH
}

extern "C" void kernel_launch(void* const* d_in, const int* in_sizes, int n_in, void* d_out, int out_size, void* d_ws, size_t ws_size, hipStream_t stream) {
    static int grid = 0;
    if (grid == 0) {
        if (n_in != 33 || ws_size < WS_END) { fprintf(stderr, "kernel_launch: unexpected n_in %d / ws_size %zu (need %zu)\n", n_in, ws_size, (size_t)WS_END); grid = -1; return; }
        int dev = 0, cus = 0, per_cu = 0;
        hipGetDevice(&dev);
        hipDeviceGetAttribute(&cus, hipDeviceAttributeMultiprocessorCount, dev);
        if (hipFuncSetAttribute((const void*)mega, hipFuncAttributeMaxDynamicSharedMemorySize, LDS_BYTES) != hipSuccess) { fprintf(stderr, "kernel_launch: hipFuncSetAttribute failed\n"); grid = -1; return; }
        hipOccupancyMaxActiveBlocksPerMultiprocessor(&per_cu, (const void*)mega, NTHR, LDS_BYTES);
        if (per_cu < 1) { fprintf(stderr, "kernel_launch: occupancy query says %d blocks per CU\n", per_cu); per_cu = 1; }
        (void)hipGetLastError();
        grid = cus;
        if (grid % 8) grid -= grid % 8;
    }
    if (grid < 0) return;
    Params p{};
    for (int i = 0; i < 33; ++i) p.in[i] = (const float*)d_in[i];
    p.out = (float*)d_out; p.ws = (unsigned char*)d_ws;
#if ONE_LAUNCH
    p.ph_lo = 0; p.ph_hi = NPHASE;
    void* args[] = {&p};
    hipError_t e = hipLaunchCooperativeKernel((const void*)mega, dim3(grid), dim3(NTHR), args, LDS_BYTES, stream);
    if (e != hipSuccess) fprintf(stderr, "cooperative launch failed: %s (grid %d)\n", hipGetErrorString(e), grid);
#else
    for (int ph = 0; ph < NPHASE; ++ph) {
        p.ph_lo = ph; p.ph_hi = ph + 1;
        hipLaunchKernelGGL(mega, dim3(grid), dim3(NTHR), LDS_BYTES, stream, p);
    }
#endif
}
```

```cpp
#include <hip/hip_runtime.h>
#include <hip/hip_cooperative_groups.h>
#include <cstdio>
#include <cstdint>
namespace cg = cooperative_groups;

#ifndef ONE_LAUNCH
#define ONE_LAUNCH 1
#endif

#define DI __device__ __forceinline__
typedef unsigned short u16;
typedef short bf16x8 __attribute__((ext_vector_type(8)));
typedef short s16x4 __attribute__((ext_vector_type(4)));
typedef float f32x2 __attribute__((ext_vector_type(2)));
typedef float f32x4 __attribute__((ext_vector_type(4)));
typedef float f32x16 __attribute__((ext_vector_type(16)));
typedef unsigned u32x2 __attribute__((ext_vector_type(2)));
typedef unsigned u32x4 __attribute__((ext_vector_type(4)));
typedef __bf16 bf16x2_t __attribute__((ext_vector_type(2)));

DI unsigned pack2(float a, float b) { f32x2 v = {a, b}; bf16x2_t r = __builtin_convertvector(v, bf16x2_t); return __builtin_bit_cast(unsigned, r); }
DI u16 f2bf(float a) { return (u16)(pack2(a, 0.f) & 0xffffu); }
DI float bflo(unsigned w) { return __uint_as_float(w << 16); }
DI float bfhi(unsigned w) { return __uint_as_float(w & 0xffff0000u); }
DI float bf2f(u16 v) { return __uint_as_float(((unsigned)v) << 16); }
#define MFMA16(a, b, c) __builtin_amdgcn_mfma_f32_16x16x32_bf16((a), (b), (c), 0, 0, 0)
#define MFMA32(a, b, c) __builtin_amdgcn_mfma_f32_32x32x16_bf16((a), (b), (c), 0, 0, 0)
DI float rcpf_(float x) { return __builtin_amdgcn_rcpf(x); }
DI float sigmoidf_(float z) { return rcpf_(1.f + __expf(-z)); }
DI float siluf_(float z) { return z * rcpf_(1.f + __expf(-z)); }
DI float ex2(float x) { return __builtin_amdgcn_exp2f(x); }
DI float xor32_max(float x) { auto t = __builtin_amdgcn_permlane32_swap(__float_as_uint(x), __float_as_uint(x), false, false); return fmaxf(__uint_as_float(t[0]), __uint_as_float(t[1])); }
DI float xor32_sum(float x) { auto t = __builtin_amdgcn_permlane32_swap(__float_as_uint(x), __float_as_uint(x), false, false); return __uint_as_float(t[0]) + __uint_as_float(t[1]); }
DI float xor16_sum(float x) { auto t = __builtin_amdgcn_permlane16_swap(__float_as_uint(x), __float_as_uint(x), false, false); return __uint_as_float(t[0]) + __uint_as_float(t[1]); }
template <int CTRL> DI float dpp_(float x) { return __builtin_bit_cast(float, __builtin_amdgcn_mov_dpp(__builtin_bit_cast(int, x), CTRL, 0xf, 0xf, true)); }
DI float quad_sum(float x) { x += dpp_<0xB1>(x); x += dpp_<0x4E>(x); return x; }
DI int tid_() { int t = threadIdx.x; asm volatile("" : "+v"(t)); return t; }
#define CFENCE asm volatile("" ::: "memory")
#define LBAR() do { asm volatile("s_waitcnt lgkmcnt(0)" ::: "memory"); __builtin_amdgcn_s_barrier(); asm volatile("" ::: "memory"); } while (0)

constexpr int NTHR = 512;
constexpr int TOK = 65536, SEQ = 2048, NBATCH = 32, DM = 1024;
constexpr int LDZ0 = 2816, LDZ1 = 4608, LDMIX = 1280;
constexpr float EPS = 1e-6f;
constexpr float SC_LOG2 = 0.125f * 1.4426950408889634f;
constexpr float LOG2E = 1.4426950408889634f;

constexpr size_t OFF_WT0 = 0;
constexpr size_t OFF_WT1 = OFF_WT0 + (size_t)2816 * 1024 * 2;
constexpr size_t OFF_WO0 = OFF_WT1 + (size_t)4608 * 1024 * 2;
constexpr size_t OFF_WO1 = OFF_WO0 + (size_t)1024 * 1280 * 2;
constexpr size_t OFF_WM = OFF_WO1 + (size_t)1024 * 1280 * 2;
constexpr size_t OFF_W1K = OFF_WM + (size_t)2 * 512 * 1024 * 2;
constexpr size_t OFF_W1V = OFF_W1K + (size_t)256 * 2048 * 2;
constexpr size_t OFF_COS = OFF_W1V + (size_t)256 * 2048 * 2;
constexpr size_t OFF_SIN = OFF_COS + (size_t)2048 * 32 * 4;
constexpr size_t OFF_RS0 = OFF_SIN + (size_t)2048 * 32 * 4;
constexpr size_t OFF_RS1 = OFF_RS0 + (size_t)TOK * 4;
constexpr size_t OFF_RSM = OFF_RS1 + (size_t)TOK * 4;
constexpr size_t OFF_BIAS = OFF_RSM + (size_t)8192 * 4;
constexpr size_t OFF_CTR = OFF_BIAS + 1024;
constexpr size_t OFF_BAR = OFF_CTR + 512;
constexpr size_t OFF_KC = OFF_CTR + 1024;
constexpr size_t OFF_VC = OFF_KC + (size_t)32 * 128 * 128 * 2;
constexpr size_t OFF_MKV = OFF_VC + (size_t)32 * 128 * 128 * 2;
constexpr size_t OFF_MEMB = OFF_MKV + (size_t)2 * 8192 * 512 * 2;
constexpr size_t OFF_XB = OFF_MEMB + (size_t)8192 * 1024 * 2;
constexpr size_t OFF_MIX = OFF_XB + (size_t)TOK * 1024 * 2;
constexpr size_t OFF_Z = OFF_MIX + (size_t)TOK * 1280 * 2;
constexpr size_t OFF_RSP = OFF_Z + (size_t)TOK * 4608 * 2;
constexpr size_t WS_END = OFF_RSP + (size_t)4 * TOK * 4;

struct Params { const float* in[33]; float* out; unsigned char* ws; int ph_lo, ph_hi; };

constexpr int LDS_BYTES = 155776;
constexpr int LDS_TR = 131072, LDS_RED = 147456;
constexpr int GP = 72;
constexpr int GP2 = 136;

struct ALPlain { const u16* A; int lda; static constexpr int dummy = 0; int kstride;
    DI const u16* rowptr(int row) const { return A + (size_t)row * lda; } };
struct ALCmp { const u16* Zc; int kstride;
    DI const u16* rowptr(int row) const { return Zc; } };

template <class Epi, bool CMP>
DI void gemm_unit(unsigned char* lds, const u16* Abase, int lda, int kstrideA, const u16* Bt, int ldb, int nk, int pm, int pn, Epi& epi) {
    const int tid = tid_(), wid = tid >> 6, lane = tid & 63, fr = lane & 15, fq = lane >> 4;
    const int wm = wid >> 2, wn = wid & 3;
    u16* As = (u16*)lds; u16* Bs = As + 2 * 256 * GP;
    const int lrow = tid >> 3, lc8 = (tid & 7) * 8;
    const u16* ap0; const u16* bp0 = Bt + (size_t)(pn * 256 + lrow) * ldb + lc8;
    const size_t bstep = (size_t)64 * ldb;
    const int atok0 = 16 * (lrow >> 1);
    if (CMP) ap0 = Abase + (size_t)(pm * SEQ) * lda + 64 * (lrow & 1) + lc8;
    else ap0 = Abase + (size_t)(pm * 256 + lrow) * lda + lc8;
    const size_t astep = (size_t)64 * lda;
    f32x4 acc[8][4];
#pragma unroll
    for (int a = 0; a < 8; ++a)
#pragma unroll
        for (int b = 0; b < 4; ++b) acc[a][b] = (f32x4){0.f, 0.f, 0.f, 0.f};
    u32x4 ra[4], rb[4];
#pragma unroll
    for (int i = 0; i < 4; ++i) {
        if (CMP) { int t = atok0 + 512 * i; t = t > SEQ - 1 ? SEQ - 1 : t; ra[i] = *(const u32x4*)(ap0 + (size_t)t * lda); }
        else ra[i] = *(const u32x4*)(ap0 + i * astep);
        rb[i] = *(const u32x4*)(bp0 + i * bstep);
    }
    __syncthreads();
#pragma unroll
    for (int i = 0; i < 4; ++i) { *(u32x4*)(As + (lrow + 64 * i) * GP + lc8) = ra[i]; *(u32x4*)(Bs + (lrow + 64 * i) * GP + lc8) = rb[i]; }
    __syncthreads();
    for (int kt = 0; kt < nk; ++kt) {
        const int buf = kt & 1;
        if (kt + 1 < nk) {
#pragma unroll
            for (int i = 0; i < 4; ++i) {
                if (CMP) { int t = atok0 + 512 * i + kt + 1; t = t > SEQ - 1 ? SEQ - 1 : t; ra[i] = *(const u32x4*)(ap0 + (size_t)t * lda); }
                else ra[i] = *(const u32x4*)(ap0 + i * astep + (size_t)(kt + 1) * kstrideA);
                rb[i] = *(const u32x4*)(bp0 + i * bstep + (size_t)(kt + 1) * 64);
            }
        }
        const u16* Ab = As + buf * 256 * GP + (128 * wm + fr) * GP + 8 * fq;
        const u16* Bb = Bs + buf * 256 * GP + (64 * wn + fr) * GP + 8 * fq;
#pragma unroll
        for (int ks = 0; ks < 2; ++ks) {
            bf16x8 bfr[4];
#pragma unroll
            for (int ni = 0; ni < 4; ++ni) bfr[ni] = *(const bf16x8*)(Bb + 16 * ni * GP + 32 * ks);
#pragma unroll
            for (int mi = 0; mi < 8; ++mi) {
                const bf16x8 afr = *(const bf16x8*)(Ab + 16 * mi * GP + 32 * ks);
#pragma unroll
                for (int ni = 0; ni < 4; ++ni) acc[mi][ni] = MFMA16(bfr[ni], afr, acc[mi][ni]);
            }
        }
        if (kt + 1 < nk) {
            u16* Aw = As + (buf ^ 1) * 256 * GP; u16* Bw = Bs + (buf ^ 1) * 256 * GP;
#pragma unroll
            for (int i = 0; i < 4; ++i) { *(u32x4*)(Aw + (lrow + 64 * i) * GP + lc8) = ra[i]; *(u32x4*)(Bw + (lrow + 64 * i) * GP + lc8) = rb[i]; }
        }
        LBAR();
    }
    epi(acc, pm * 256 + 128 * wm, pn * 256 + 64 * wn, lane, lds);
}


namespace pg8 {
#define PG8_LAS __attribute__((address_space(3)))
constexpr int BM = 256, BK = 64, HALF = 128, HTB = HALF * BK * 2, STAGE_BYTES = 8 * HTB;
DI int lds_byte(int r, int c) { const int st = (r >> 4) * 2 + (c >> 5), rr = r & 15, cc = c & 31, ob = rr * 64 + cc * 2; return st * 1024 + (ob ^ (((ob >> 9) & 1) << 5)); }
DI void stage_rc(int b, int& R, int& C) { const int st = b / 1024, sb = b % 1024, swz = sb ^ (((sb >> 9) & 1) << 5); R = (st >> 1) * 16 + swz / 64; C = (st & 1) * 32 + (swz % 64) / 2; }
struct Unit { int pm, pn; };
struct Gemm { const u16* A; const u16* Bt; int K; };

template <class Epi, class Sched, bool ALIGN_EPI>
DI void gemm_phase(PG8_LAS unsigned char* lds, const Gemm g, const Sched& S, Epi& E) {
    const int tid = tid_(), wid = __builtin_amdgcn_readfirstlane(tid >> 6), lane = tid & 63, wr = wid >> 2, wc = wid & 3, fr = lane & 15, fq = lane >> 4;
    const int K = g.K, nt = K / BK;
    unsigned voffA[2];
#pragma unroll
    for (int i = 0; i < 2; ++i) { int R, C; stage_rc(tid * 16 + i * 8192, R, C); voffA[i] = (unsigned)(R * K + C) * 2u; }
    const size_t kstep = (size_t)(BK * 2);
    const size_t hstep = (size_t)HALF * K * 2;
    const size_t tstep = 2 * hstep;
    const unsigned ldsw = (unsigned)wid * 1024u;
    const int aoff = lds_byte(wr * 64 + fr, fq * 8), boff = lds_byte(wc * 32 + fr, fq * 8);
#define PG8_SA(b, h) (((b) * 2 + (h)) * HTB)
#define PG8_SB(b, h) ((4 + (b) * 2 + (h)) * HTB)
#define PG8_STAGE(bufoff, gbase) do { _Pragma("unroll") for (int _i = 0; _i < 2; ++_i) \
        __builtin_amdgcn_global_load_lds((const unsigned*)((const char*)(gbase) + voffA[_i]), (PG8_LAS unsigned*)(lds + (bufoff) + ldsw + _i * 8192), 16, 0, 0); } while (0)
#define PG8_LDA(dst, b, h) do { _Pragma("unroll") for (int m = 0; m < 4; ++m) _Pragma("unroll") for (int k = 0; k < 2; ++k) dst[m][k] = *(const PG8_LAS bf16x8*)(lds + PG8_SA(b, h) + aoff + m * 2048 + k * 1024); } while (0)
#define PG8_LDB(dst, b, h) do { _Pragma("unroll") for (int n = 0; n < 2; ++n) _Pragma("unroll") for (int k = 0; k < 2; ++k) dst[n][k] = *(const PG8_LAS bf16x8*)(lds + PG8_SB(b, h) + boff + n * 2048 + k * 1024); } while (0)
#define PG8_MMA(ai, bj, At, Bt) do { __builtin_amdgcn_s_setprio(1); _Pragma("unroll") for (int m = 0; m < 4; ++m) _Pragma("unroll") for (int n = 0; n < 2; ++n) _Pragma("unroll") for (int k = 0; k < 2; ++k) \
        acc[ai][bj][m][n] = __builtin_amdgcn_mfma_f32_16x16x32_bf16(Bt[n][k], At[m][k], acc[ai][bj][m][n], 0, 0, 0); __builtin_amdgcn_s_setprio(0); } while (0)
#define PG8_WAIT_V(n) asm volatile("s_waitcnt vmcnt(" #n ")" ::: "memory")
#define PG8_WAIT_L(n) asm volatile("s_waitcnt lgkmcnt(" #n ")" ::: "memory")
#define PG8_BAR __builtin_amdgcn_s_barrier()
#define PG8_SCHED __builtin_amdgcn_sched_barrier(0)
    Unit cur, nxt; int ui = 0;
    if (!S.next(0, cur)) return;
    f32x4 acc[2][2][4][2];
#pragma unroll
    for (int a = 0; a < 2; ++a)
#pragma unroll
        for (int b = 0; b < 2; ++b)
#pragma unroll
            for (int m = 0; m < 4; ++m)
#pragma unroll
                for (int n = 0; n < 2; ++n) acc[a][b][m][n] = (f32x4){0.f, 0.f, 0.f, 0.f};
    bf16x8 At[4][2], B0[2][2], B1[2][2];
    const char* cA = (const char*)g.A + (size_t)cur.pm * tstep; const char* cB = (const char*)g.Bt + (size_t)cur.pn * tstep;
    E.pre(cur, wr, fr);
    PG8_STAGE(PG8_SB(0, 0), cB); PG8_STAGE(PG8_SB(0, 1), cB + hstep); PG8_STAGE(PG8_SA(0, 0), cA); PG8_STAGE(PG8_SA(0, 1), cA + hstep);
    if (wr == 1) PG8_BAR;
    PG8_WAIT_V(2); PG8_BAR;
    PG8_STAGE(PG8_SB(1, 0), cB + kstep); PG8_STAGE(PG8_SA(1, 0), cA + kstep); PG8_STAGE(PG8_SB(1, 1), cB + hstep + kstep);
    PG8_WAIT_V(6); PG8_BAR;
    for (;;) {
        const bool has_next = S.next(ui + 1, nxt);
        const char* nA = has_next ? (const char*)g.A + (size_t)nxt.pm * tstep : cA; const char* nB = has_next ? (const char*)g.Bt + (size_t)nxt.pn * tstep : cB;
        for (int t = 0; t < nt; t += 2) {
            const bool last = (t == nt - 2);
            const char* a1 = cA + (size_t)(t + 1) * kstep;
            const char* a2 = last ? nA : cA + (size_t)(t + 2) * kstep; const char* b2 = last ? nB : cB + (size_t)(t + 2) * kstep;
            const char* a3 = a2 + kstep; const char* b3 = b2 + kstep;
            PG8_LDB(B0, 0, 0); PG8_LDB(B1, 0, 1); PG8_SCHED; PG8_LDA(At, 0, 0); PG8_STAGE(PG8_SA(1, 1), a1 + hstep);
            PG8_WAIT_V(8); PG8_WAIT_L(0); PG8_BAR; PG8_MMA(0, 0, At, B0); PG8_MMA(0, 1, At, B1); PG8_BAR; PG8_SCHED;
            PG8_LDA(At, 0, 1); PG8_STAGE(PG8_SB(0, 0), b2); PG8_STAGE(PG8_SB(0, 1), b2 + hstep); PG8_STAGE(PG8_SA(0, 0), a2);
            PG8_WAIT_V(8); PG8_WAIT_L(0); PG8_BAR; PG8_MMA(1, 0, At, B0); PG8_MMA(1, 1, At, B1); PG8_BAR; PG8_SCHED;
            PG8_LDB(B0, 1, 0); PG8_LDB(B1, 1, 1); PG8_SCHED; PG8_LDA(At, 1, 0); PG8_STAGE(PG8_SA(0, 1), a2 + hstep);
            PG8_WAIT_V(8); PG8_WAIT_L(0); PG8_BAR; PG8_MMA(0, 0, At, B0); PG8_MMA(0, 1, At, B1); PG8_BAR; PG8_SCHED;
            PG8_LDA(At, 1, 1); PG8_STAGE(PG8_SB(1, 0), b3); PG8_STAGE(PG8_SB(1, 1), b3 + hstep); PG8_STAGE(PG8_SA(1, 0), a3);
            PG8_WAIT_V(8); PG8_WAIT_L(0); PG8_BAR; PG8_MMA(1, 0, At, B0); PG8_MMA(1, 1, At, B1); PG8_BAR; PG8_SCHED;
        }
        if constexpr (ALIGN_EPI) { if (wr == 0) PG8_BAR; }
        E(acc, cur, wr, wc, fr, fq);
        if (!has_next) break;
#pragma unroll
        for (int a = 0; a < 2; ++a)
#pragma unroll
            for (int b = 0; b < 2; ++b)
#pragma unroll
                for (int m = 0; m < 4; ++m)
#pragma unroll
                    for (int n = 0; n < 2; ++n) acc[a][b][m][n] = (f32x4){0.f, 0.f, 0.f, 0.f};
        cur = nxt; cA = nA; cB = nB; ++ui;
        E.pre(cur, wr, fr);
        if constexpr (ALIGN_EPI) { if (wr == 1) PG8_BAR; }
    }
    PG8_WAIT_V(0);
    if constexpr (!ALIGN_EPI) { if (wr == 0) PG8_BAR; }
    PG8_BAR;
#undef PG8_SA
#undef PG8_SB
#undef PG8_STAGE
#undef PG8_LDA
#undef PG8_LDB
#undef PG8_MMA
#undef PG8_WAIT_V
#undef PG8_WAIT_L
#undef PG8_BAR
#undef PG8_SCHED
}
struct SchedIn { int NT, per, slot, xcd;
    DI bool next(int i, Unit& u) const { const int U = slot + i * per; if (U >= 32 * NT) return false; const int g = U / (8 * NT), r = U - g * 8 * NT; u.pm = xcd * 32 + 8 * g + (r & 7); u.pn = r >> 3; return true; } };
struct SchedOut { int pm;
    DI bool next(int i, Unit& u) const { if (i >= 4) return false; u.pm = pm; u.pn = i; return true; } };
struct SchedOutX { int per, slot, xcd;
    DI bool next(int i, Unit& u) const { const int U = slot + i * per; if (U >= 128) return false; u.pm = xcd * 32 + 8 * (U >> 5) + (U & 7); u.pn = (U & 31) >> 3; return true; } };
struct SchedOne { int pm, pn; bool on;
    DI bool next(int i, Unit& u) const { if (i > 0 || !on) return false; u.pm = pm; u.pn = pn; return true; } };
}


DI void tr_put8(unsigned char* T, int fr, int chunk, int half8, u32x2 w) { *(u32x2*)(T + fr * 128 + ((chunk ^ (fr & 7)) << 4) + half8 * 8) = w; }
DI void tr_put16(unsigned char* T, int fr, int chunk, f32x4 w) { *(f32x4*)(T + fr * 128 + ((chunk ^ (fr & 7)) << 4)) = w; }
DI u32x4 tr_get(const unsigned char* T, int r, int chunk) { return *(const u32x4*)(T + r * 128 + ((chunk ^ (r & 7)) << 4)); }

enum { OP_PLAIN = 0, OP_NORMROPE = 1, OP_NORM = 2, OP_SILU = 3, OP_SIGMOID = 4, OP_LOGF = 5 };

struct EpiZ {
    u16* Z; int ldz; const float* rs; int layer; const Params* p; const float* cs; const float* sn; unsigned char* tr; bool rs4;
    DI void pre(const pg8::Unit&, int, int) {}
    DI void operator()(f32x4 (&acc)[2][2][4][2], const pg8::Unit& u, int wr, int wc, int fr, int fq) {
        asm volatile("" : "+v"(fr), "+v"(fq));
        const int row0 = 256 * u.pm + 64 * wr, col0 = 256 * u.pn + 64 * wc, grp = col0 >> 6;
        int op = OP_PLAIN; const float* gain = nullptr;
        if (layer == 0) {
            if (grp < 8) { op = OP_NORMROPE; gain = p->in[9]; }
            else if (grp < 10) { op = OP_NORMROPE; gain = p->in[10]; }
            else if (grp < 12) op = OP_PLAIN;
            else if (grp < 20) op = OP_SILU;
            else if (grp < 28) op = OP_PLAIN;
            else if (grp < 36) op = OP_SILU;
            else if (grp < 40) { op = OP_NORM; gain = p->in[5]; }
            else op = OP_SILU;
        } else if (layer == 1) {
            if (grp < 8) op = OP_SILU;
            else if (grp < 16) op = OP_LOGF;
            else if (grp < 24) op = OP_PLAIN;
            else if (grp < 32) op = OP_SILU;
            else if (grp < 40) { op = OP_NORMROPE; gain = p->in[23]; }
            else if (grp < 44) op = OP_PLAIN;
            else if (grp < 46) { op = OP_NORMROPE; gain = p->in[25]; }
            else if (grp < 48) op = OP_PLAIN;
            else if (grp < 50) { op = OP_NORMROPE; gain = p->in[26]; }
            else if (grp < 52) op = OP_PLAIN;
            else if (grp < 60) op = OP_SILU;
            else if (grp < 64) { op = OP_NORM; gain = p->in[5] + 64; }
            else if (grp < 68) op = OP_SILU;
            else if (grp < 69) op = OP_SIGMOID;
            else op = OP_PLAIN;
        } else {
            if (grp < 4) { op = OP_NORM; gain = p->in[6] + 64 * (layer - 2); }
            else op = OP_PLAIN;
        }
        f32x4 gn[4];
        if (op == OP_NORMROPE || op == OP_NORM) {
#pragma unroll
            for (int ni = 0; ni < 4; ++ni) gn[ni] = *(const f32x4*)(gain + 16 * ni + 4 * fq);
        } else if (op == OP_LOGF) {
            const float* lbp = p->in[21]; const int ch0 = (grp - 8) * 64;
#pragma unroll
            for (int ni = 0; ni < 4; ++ni) {
                const f32x4 p0 = *(const f32x4*)(lbp + ch0 + 16 * ni + 4 * fq), p1 = *(const f32x4*)(lbp + 512 + ch0 + 16 * ni + 4 * fq);
#pragma unroll
                for (int r = 0; r < 4; ++r) gn[ni][r] = 1.f / (1.f + expf(p0[r] - p1[r]));
            }
        }
        float rsv[8];
#pragma unroll
        for (int mi = 0; mi < 8; ++mi) {
            const float* rp = rs + row0 + 128 * (mi >> 2) + 16 * (mi & 3) + fr;
            rsv[mi] = rs4 ? rsqrtf(((rp[0] + rp[TOK]) + (rp[2 * TOK] + rp[3 * TOK])) * (1.f / 1024.f) + EPS) : rp[0];
        }
        f32x4 invf[2];
        if (op == OP_NORMROPE) {
#pragma unroll
            for (int ni = 0; ni < 2; ++ni)
#pragma unroll
                for (int r = 0; r < 4; ++r) invf[ni][r] = exp2f(-(float)(16 * ni + 4 * fq + r) * (13.287712379549449f / 32.f)) * 0.15915494309189535f;
        }
#pragma unroll
        for (int mi = 0; mi < 8; ++mi) {
            const int row = row0 + 128 * (mi >> 2) + 16 * (mi & 3) + fr;
            const float s = rsv[mi];
            f32x4 v[4];
#pragma unroll
            for (int ni = 0; ni < 4; ++ni) v[ni] = acc[mi >> 2][ni >> 1][mi & 3][ni & 1] * s;
            if (op == OP_NORMROPE || op == OP_NORM) {
                float ss = 0.f;
#pragma unroll
                for (int ni = 0; ni < 4; ++ni) ss += v[ni][0] * v[ni][0] + v[ni][1] * v[ni][1] + v[ni][2] * v[ni][2] + v[ni][3] * v[ni][3];
                ss = xor32_sum(xor16_sum(ss));
                const float inv = rsqrtf(ss * (1.f / 64.f) + EPS);
#pragma unroll
                for (int ni = 0; ni < 4; ++ni) v[ni] = v[ni] * inv * gn[ni];
                if (op == OP_NORMROPE) {
#pragma unroll
                    for (int ni = 0; ni < 2; ++ni) {
                        const float tf = (float)(row & (SEQ - 1));
                        f32x4 c, sv;
#pragma unroll
                        for (int r = 0; r < 4; ++r) { const float fx = __builtin_amdgcn_fractf(tf * invf[ni][r]); c[r] = __builtin_amdgcn_cosf(fx); sv[r] = __builtin_amdgcn_sinf(fx); }
                        const f32x4 x1 = v[ni], x2 = v[ni + 2];
                        v[ni] = x1 * c - x2 * sv; v[ni + 2] = x2 * c + x1 * sv;
                    }
                }
            } else if (op == OP_SILU) {
#pragma unroll
                for (int ni = 0; ni < 4; ++ni)
#pragma unroll
                    for (int r = 0; r < 4; ++r) v[ni][r] = siluf_(v[ni][r]);
            } else if (op == OP_SIGMOID) {
#pragma unroll
                for (int ni = 0; ni < 4; ++ni)
#pragma unroll
                    for (int r = 0; r < 4; ++r) v[ni][r] = sigmoidf_(v[ni][r]);
            } else if (op == OP_LOGF) {
#pragma unroll
                for (int ni = 0; ni < 4; ++ni)
#pragma unroll
                    for (int r = 0; r < 4; ++r) { const float lb = gn[ni][r]; v[ni][r] = __logf(lb + (1.f - lb) * sigmoidf_(v[ni][r])); }
            }
#pragma unroll
            for (int ni = 0; ni < 4; ++ni) { u32x2 w; w.x = pack2(v[ni][0], v[ni][1]); w.y = pack2(v[ni][2], v[ni][3]); tr_put8(tr, fr, 2 * ni + (fq >> 1), fq & 1, w); }
            {
                const int lane = fr + 16 * fq, c8 = lane & 7;
                const int rb = row0 + 128 * (mi >> 2) + 16 * (mi & 3);
#pragma unroll
                for (int k = 0; k < 2; ++k) { const int r = (lane >> 3) + 8 * k; __builtin_nontemporal_store(tr_get(tr, r, c8), (u32x4*)(Z + (size_t)(rb + r) * ldz + col0 + 8 * c8)); }
            }
            CFENCE;
        }
    }
};

struct EpiOut0 {
    const float* x; float* out; u16* xb; float* red; unsigned char* tr; float* rsp;
    int par, ppm, ppn;
    DI void pre(const pg8::Unit&, int, int) {}
    DI void flush(int wr, int wc, int fr, int fq) {
        if (ppm >= 0 && wc == 0 && fq == 0) {
            const float* rd = red + (par ^ 1) * 1024;
#pragma unroll
            for (int mi = 0; mi < 8; ++mi) {
                const int r = 64 * wr + 128 * (mi >> 2) + 16 * (mi & 3) + fr;
                rsp[(size_t)ppn * TOK + 256 * ppm + r] = (rd[r] + rd[256 + r]) + (rd[512 + r] + rd[768 + r]);
            }
        }
    }
    DI void operator()(f32x4 (&acc)[2][2][4][2], const pg8::Unit& u, int wr, int wc, int fr, int fq) {
        asm volatile("" : "+v"(fr), "+v"(fq));
        const int row0 = 256 * u.pm + 64 * wr, col0 = 256 * u.pn + 64 * wc;
        const int lane = fr + 16 * fq, c8 = lane & 7, lr = lane >> 3;
        f32x4 xr[2][2];
#pragma unroll
        for (int k = 0; k < 2; ++k) xr[0][k] = __builtin_nontemporal_load((const f32x4*)(x + (size_t)(row0 + lr + 8 * k) * DM + col0 + 4 * c8));
        flush(wr, wc, fr, fq);
        float* rw = red + par * 1024 + wc * 256 + 64 * wr;
        float ss = 0.f; u32x2 wq[2][2];
#pragma unroll
        for (int st = 0; st < 16; ++st) {
            const int mi = st >> 1, hh = st & 1;
            const int rl = 128 * (mi >> 2) + 16 * (mi & 3) + fr;
            if (st < 15) {
                const int mn = (st + 1) >> 1, hn = (st + 1) & 1;
                const int rbn = row0 + 128 * (mn >> 2) + 16 * (mn & 3);
#pragma unroll
                for (int k = 0; k < 2; ++k) xr[(st + 1) & 1][k] = __builtin_nontemporal_load((const f32x4*)(x + (size_t)(rbn + lr + 8 * k) * DM + col0 + 32 * hn + 4 * c8));
            }
#pragma unroll
            for (int k = 0; k < 2; ++k) tr_put16(tr, lr + 8 * k, c8, xr[st & 1][k]);
#pragma unroll
            for (int n = 0; n < 2; ++n) {
                const f32x4 xv = *(const f32x4*)(tr + fr * 128 + (((4 * n + fq) ^ (fr & 7)) << 4));
                const f32x4 v = acc[mi >> 2][hh][mi & 3][n] + xv;
                wq[hh][n].x = pack2(v[0], v[1]); wq[hh][n].y = pack2(v[2], v[3]);
                ss += v[0] * v[0] + v[1] * v[1] + v[2] * v[2] + v[3] * v[3];
            }
            if (hh) {
                ss = xor32_sum(xor16_sum(ss));
                if (fq == 0) rw[rl] = ss;
                ss = 0.f;
#pragma unroll
                for (int h2 = 0; h2 < 2; ++h2)
#pragma unroll
                    for (int n = 0; n < 2; ++n) tr_put8(tr, fr, 2 * (2 * h2 + n) + (fq >> 1), fq & 1, wq[h2][n]);
                const int rb = row0 + 128 * (mi >> 2) + 16 * (mi & 3);
#pragma unroll
                for (int k = 0; k < 2; ++k) { const int r = lr + 8 * k; *(u32x4*)(xb + (size_t)(rb + r) * DM + col0 + 8 * c8) = tr_get(tr, r, c8); }
            }
            CFENCE;
        }
        ppm = u.pm; ppn = u.pn; par ^= 1;
    }
};
struct EpiOut1 {
    float* out; const u16* xb; unsigned char* tr;
    DI void pre(const pg8::Unit&, int, int) {}
    DI void operator()(f32x4 (&acc)[2][2][4][2], const pg8::Unit& u, int wr, int wc, int fr, int fq) const {
        asm volatile("" : "+v"(fr), "+v"(fq));
        const int row0 = 256 * u.pm + 64 * wr, col0 = 256 * u.pn + 64 * wc;
        const int lane = fr + 16 * fq, c8 = lane & 7, lr = lane >> 3;
        u32x4 hb[2][2];
#pragma unroll
        for (int k = 0; k < 2; ++k) hb[0][k] = *(const u32x4*)(xb + (size_t)(row0 + lr + 8 * k) * DM + col0 + 8 * c8);
#pragma unroll
        for (int mi = 0; mi < 8; ++mi) {
            const int rb = row0 + 128 * (mi >> 2) + 16 * (mi & 3);
            if (mi < 7) {
                const int rbn = row0 + 128 * ((mi + 1) >> 2) + 16 * ((mi + 1) & 3);
#pragma unroll
                for (int k = 0; k < 2; ++k) hb[(mi + 1) & 1][k] = *(const u32x4*)(xb + (size_t)(rbn + lr + 8 * k) * DM + col0 + 8 * c8);
            }
#pragma unroll
            for (int k = 0; k < 2; ++k) { const int r = lr + 8 * k; *(u32x4*)(tr + r * 128 + ((c8 ^ (r & 7)) << 4)) = hb[mi & 1][k]; }
            u32x2 hw[4];
#pragma unroll
            for (int ni = 0; ni < 4; ++ni) hw[ni] = *(const u32x2*)(tr + fr * 128 + (((2 * ni + (fq >> 1)) ^ (fr & 7)) << 4) + 8 * (fq & 1));
#pragma unroll
            for (int hh = 0; hh < 2; ++hh) {
#pragma unroll
                for (int n = 0; n < 2; ++n) {
                    const u32x2 w = hw[2 * hh + n];
                    const f32x4 a = acc[mi >> 2][hh][mi & 3][n];
                    tr_put16(tr, fr, 4 * n + fq, (f32x4){bflo(w.x) + a[0], bfhi(w.x) + a[1], bflo(w.y) + a[2], bfhi(w.y) + a[3]});
                }
#pragma unroll
                for (int k = 0; k < 2; ++k) { const int r = lr + 8 * k; __builtin_nontemporal_store(tr_get(tr, r, c8), (u32x4*)(out + (size_t)(rb + r) * DM + col0 + 32 * hh + 4 * c8)); }
            }
            CFENCE;
        }
    }
};

struct EpiCmp {
    const float* bias; const float* w2; const float* gain; u16* dst; bool isk; const float* cs; const float* sn;
    DI void operator()(f32x4 (&acc)[8][4], int row0, int col0, int lane, unsigned char* lds) const {
        const int fr = lane & 15, fq = lane >> 4, tid = tid_();
        float* Hs = (float*)lds;
        if (col0 < 128) {
            const int lrow0 = row0 & 255;
#pragma unroll
            for (int mi = 0; mi < 8; ++mi)
#pragma unroll
                for (int ni = 0; ni < 4; ++ni)
#pragma unroll
                    for (int r = 0; r < 4; ++r) { const int c = col0 + 16 * ni + 4 * fq + r; Hs[(lrow0 + 16 * mi + fr) * 129 + c] = siluf_(acc[mi][ni][r] + bias[c]); }
        }
        __syncthreads();
        const int lrow = tid >> 1, half = tid & 1;
        const int row = (row0 & ~255) + lrow;
        float o[32];
#pragma unroll
        for (int c = 0; c < 32; ++c) o[c] = 0.f;
        for (int j = 0; j < 128; ++j) {
            const float hv = Hs[lrow * 129 + j];
            const float* wr = w2 + j * 64 + 32 * half;
#pragma unroll
            for (int c4 = 0; c4 < 8; ++c4) { const f32x4 w = *(const f32x4*)(wr + 4 * c4); o[4 * c4] += hv * w[0]; o[4 * c4 + 1] += hv * w[1]; o[4 * c4 + 2] += hv * w[2]; o[4 * c4 + 3] += hv * w[3]; }
        }
        if (isk) {
            float ss = 0.f;
#pragma unroll
            for (int c = 0; c < 32; ++c) ss += o[c] * o[c];
            ss += __shfl_xor(ss, 1);
            const float inv = rsqrtf(ss * (1.f / 64.f) + EPS);
            const int n = (row >> 1) & 127; int t = 16 * n + 31; t = t > SEQ - 1 ? SEQ - 1 : t;
#pragma unroll
            for (int c = 0; c < 32; ++c) {
                const float mine = o[c] * inv * gain[32 * half + c];
                const float other = __shfl_xor(mine, 1);
                const float cv = cs[t * 32 + c], sv = sn[t * 32 + c];
                o[c] = half == 0 ? (mine * cv - other * sv) : (mine * cv + other * sv);
            }
        }
        u16* dp = dst + (size_t)row * 64 + 32 * half;
#pragma unroll
        for (int c8 = 0; c8 < 4; ++c8) { u32x4 w; w.x = pack2(o[8 * c8], o[8 * c8 + 1]); w.y = pack2(o[8 * c8 + 2], o[8 * c8 + 3]); w.z = pack2(o[8 * c8 + 4], o[8 * c8 + 5]); w.w = pack2(o[8 * c8 + 6], o[8 * c8 + 7]); *(u32x4*)(dp + 8 * c8) = w; }
        __syncthreads();
    }
};

DI int srccol(int mode, int n) {
    if (mode == 0) return n;
    if (mode == 1) { if (n < 3328) return n; if (n < 4352) return n + 24; if (n < 4376) return n - 1024; return -1; }
    return n < 128 ? n : -1;
}
DI int physrow(int n) { const int w = n & 255; return (n & ~255) + 128 * ((w >> 5) & 1) + 32 * (w >> 6) + (w & 31); }
DI void tconv(unsigned char* lds, const float* src, int ldsrc, int K, int N, u16* dst, const float* gain, int mode, int first, int stride) {
    float* tl = (float*)lds;
    const int tid = tid_(), nkt = K / 64, ntile = nkt * (N / 64);
    for (int tile = first; tile < ntile; tile += stride) {
        const int k0 = (tile % nkt) * 64, n0 = (tile / nkt) * 64;
#pragma unroll
        for (int i = 0; i < 8; ++i) {
            const int k = (tid >> 6) + 8 * i, n = tid & 63; const int sc = srccol(mode, n0 + n);
            float v = 0.f; if (sc >= 0) { v = src[(size_t)(k0 + k) * ldsrc + sc]; if (gain) v *= gain[k0 + k]; }
            tl[k * 65 + n] = v;
        }
        __syncthreads();
#pragma unroll
        for (int i = 0; i < 8; ++i) { const int n = (tid >> 6) + 8 * i, k = tid & 63; const int pr = mode == 2 ? n0 + n : physrow(n0 + n); dst[(size_t)pr * K + k0 + k] = f2bf(tl[k * 65 + n]); }
        __syncthreads();
    }
}
DI void phase_prep(const Params& p, unsigned char* lds) {
    unsigned char* ws = p.ws;
    const int tid = tid_(), wid = tid >> 6, lane = tid & 63;
    if (blockIdx.x == 0 && tid < 256) ((unsigned*)(ws + OFF_CTR))[tid] = 0u;
    for (int rb = blockIdx.x; rb < (TOK + 8192) / 16; rb += gridDim.x) {
        f32x4 v[2][4]; const float* src[2]; u16* dst[2]; float* rsd[2];
#pragma unroll
        for (int h = 0; h < 2; ++h) {
            const int r = rb * 16 + 2 * wid + h;
            if (r < TOK) { src[h] = p.in[0] + (size_t)r * DM; dst[h] = (u16*)(ws + OFF_XB) + (size_t)r * DM; rsd[h] = (float*)(ws + OFF_RS0) + r; }
            else { const int rr = r - TOK; src[h] = p.in[1] + (size_t)rr * DM; dst[h] = (u16*)(ws + OFF_MEMB) + (size_t)rr * DM; rsd[h] = (float*)(ws + OFF_RSM) + rr; }
#pragma unroll
            for (int i = 0; i < 4; ++i) v[h][i] = __builtin_nontemporal_load((const f32x4*)(src[h] + 4 * (lane + 64 * i)));
        }
#pragma unroll
        for (int h = 0; h < 2; ++h) {
            float ss = 0.f;
#pragma unroll
            for (int i = 0; i < 4; ++i) ss += v[h][i][0] * v[h][i][0] + v[h][i][1] * v[h][i][1] + v[h][i][2] * v[h][i][2] + v[h][i][3] * v[h][i][3];
#pragma unroll
            for (int o = 1; o < 64; o <<= 1) ss += __shfl_xor(ss, o);
            if (lane == 0) *rsd[h] = rsqrtf(ss * (1.f / 1024.f) + EPS);
#pragma unroll
            for (int i = 0; i < 4; ++i) { u32x2 w; w.x = pack2(v[h][i][0], v[h][i][1]); w.y = pack2(v[h][i][2], v[h][i][3]); *(u32x2*)(dst[h] + 4 * (lane + 64 * i)) = w; }
        }
    }
    const int b0 = blockIdx.x, gs = gridDim.x;
    tconv(lds, p.in[7], 2816, 1024, 2816, (u16*)(ws + OFF_WT0), p.in[2], 0, b0, gs);
    tconv(lds, p.in[8], 1024, 1280, 1024, (u16*)(ws + OFF_WO0), nullptr, 0, b0, gs);
    tconv(lds, p.in[4], 512, 1024, 512, (u16*)(ws + OFF_WM), p.in[3], 0, b0, gs);
    tconv(lds, p.in[4] + (size_t)1024 * 512, 512, 1024, 512, (u16*)(ws + OFF_WM) + (size_t)512 * 1024, p.in[3] + 1024, 0, b0, gs);
    for (int idx = blockIdx.x * NTHR + tid; idx < 2048 * 32; idx += gridDim.x * NTHR) {
        const int t = idx >> 5, i = idx & 31;
        const float inv = exp2f(-(float)i * (13.287712379549449f / 32.f));
        const double rev = (double)t * (double)inv * 0.15915494309189535;
        const float fr = (float)(rev - floor(rev));
        ((float*)(ws + OFF_COS))[idx] = __builtin_amdgcn_cosf(fr);
        ((float*)(ws + OFF_SIN))[idx] = __builtin_amdgcn_sinf(fr);
    }
}
DI void prep_layer1(const Params& p, unsigned char* lds, int first, int stride) {
    unsigned char* ws = p.ws;
    const int tid = tid_(), wid = tid >> 6, lane = tid & 63;
    __syncthreads();
    tconv(lds, p.in[19], 4376, 1024, 4608, (u16*)(ws + OFF_WT1), p.in[2] + 1024, 1, first, stride);
    tconv(lds, p.in[20], 1024, 1280, 1024, (u16*)(ws + OFF_WO1), nullptr, 0, first, stride);
    tconv(lds, p.in[29], 128, 2048, 256, (u16*)(ws + OFF_W1K), nullptr, 2, first, stride);
    tconv(lds, p.in[31], 128, 2048, 256, (u16*)(ws + OFF_W1V), nullptr, 2, first, stride);
    for (int task = first; task < 32; task += stride) {
        const int kv = task >> 4, j = (task & 15) * 8 + wid;
        const float* pe = kv ? p.in[28] : p.in[27]; const float* w1 = kv ? p.in[31] : p.in[29];
        float s = 0.f;
        for (int i = lane; i < 2048; i += 64) s += pe[i] * w1[(size_t)i * 128 + j];
#pragma unroll
        for (int o = 1; o < 64; o <<= 1) s += __shfl_xor(s, o);
        if (lane == 0) ((float*)(ws + OFF_BIAS))[kv * 128 + j] = s;
    }
}

struct TileSrc { const u16* k; const u16* v; int kstride, vstride; };
DI void tile_load(const TileSrc& s, u32x4& rk, u32x4& rv, int tid) {
    rk = *(const u32x4*)(s.k + (size_t)(tid >> 3) * s.kstride + (tid & 7) * 8);
    rv = *(const u32x4*)(s.v + (size_t)(tid >> 3) * s.vstride + (tid & 7) * 8);
}
DI void tile_store(u16* Kt, u16* Vt, const u32x4& rk, const u32x4& rv, int tid) {
    *(u32x4*)(Kt + (tid >> 3) * GP + (tid & 7) * 8) = rk;
    *(u32x4*)(Vt + (tid >> 3) * GP + (tid & 7) * 8) = rv;
}
typedef __attribute__((address_space(3))) s16x4 lds_s16x4;
DI s16x4 tr_read(const u16* p) { return __builtin_amdgcn_ds_read_tr16_b64_v4i16((lds_s16x4*)p); }
struct AttnAcc { f32x16 o[2]; float m, l; };
DI void attn_reset(AttnAcc& a) {
#pragma unroll
    for (int i = 0; i < 16; ++i) { a.o[0][i] = 0.f; a.o[1][i] = 0.f; }
    a.m = -1e30f; a.l = 0.f;
}
template <int MODE, class MaskF>
DI void attn_compute(const u16* Kt, const u16* Vt, const bf16x8 (&q)[4], AttnAcc& st, int lane, bool rowon, MaskF valid) {
    const int r32 = lane & 31, h = lane >> 5;
    f32x16 X[2];
#pragma unroll
    for (int kt2 = 0; kt2 < 2; ++kt2) {
#pragma unroll
        for (int i = 0; i < 16; ++i) X[kt2][i] = 0.f;
#pragma unroll
        for (int s = 0; s < 4; ++s) { const bf16x8 kf = *(const bf16x8*)(Kt + (32 * kt2 + r32) * GP + 16 * s + 8 * h); X[kt2] = MFMA32(kf, q[s], X[kt2]); }
    }
    float mx = -1e30f;
    if (MODE == 0) {
#pragma unroll
        for (int kt2 = 0; kt2 < 2; ++kt2)
#pragma unroll
            for (int reg = 0; reg < 16; ++reg) {
                const int kl = 32 * kt2 + (reg & 3) + 8 * (reg >> 2) + 4 * h;
                float t = X[kt2][reg]; t = valid(kl) ? t : -1e30f; X[kt2][reg] = t; mx = fmaxf(mx, t);
            }
    } else {
#pragma unroll
        for (int kt2 = 0; kt2 < 2; ++kt2)
#pragma unroll
            for (int reg = 0; reg < 16; ++reg) mx = fmaxf(mx, X[kt2][reg]);
        if (MODE == 2) mx = rowon ? mx : -1e30f;
    }
    mx = xor32_max(mx);
    const float mn = fmaxf(st.m, mx > -1e29f ? mx * SC_LOG2 : -1e30f);
    const float alpha = ex2(st.m - mn);
    float rsum = 0.f;
#pragma unroll
    for (int kt2 = 0; kt2 < 2; ++kt2)
#pragma unroll
        for (int reg = 0; reg < 16; ++reg) {
            const float t = X[kt2][reg]; float pv = ex2(fmaf(t, SC_LOG2, -mn));
            if (MODE == 0) pv = t > -1e29f ? pv : 0.f;
            if (MODE == 2) pv = rowon ? pv : 0.f;
            X[kt2][reg] = pv; rsum += pv;
        }
    rsum = xor32_sum(rsum);
    st.l = st.l * alpha + rsum; st.m = mn;
#pragma unroll
    for (int i = 0; i < 16; ++i) { st.o[0][i] *= alpha; st.o[1][i] *= alpha; }
    bf16x8 pf[2][2];
#pragma unroll
    for (int kt2 = 0; kt2 < 2; ++kt2)
#pragma unroll
        for (int s = 0; s < 2; ++s) {
            u32x4 w; w.x = pack2(X[kt2][8 * s], X[kt2][8 * s + 1]); w.y = pack2(X[kt2][8 * s + 2], X[kt2][8 * s + 3]);
            w.z = pack2(X[kt2][8 * s + 4], X[kt2][8 * s + 5]); w.w = pack2(X[kt2][8 * s + 6], X[kt2][8 * s + 7]);
            pf[kt2][s] = __builtin_bit_cast(bf16x8, w);
        }
#pragma unroll
    for (int nt = 0; nt < 2; ++nt)
#pragma unroll
        for (int kt2 = 0; kt2 < 2; ++kt2)
#pragma unroll
            for (int s = 0; s < 2; ++s) {
                const u16* vp = Vt + (32 * kt2 + 16 * s + 4 * h + ((lane & 15) >> 2)) * GP + 32 * nt + 16 * ((lane >> 4) & 1) + 4 * (lane & 3);
                const s16x4 lo = tr_read(vp), hi = tr_read(vp + 8 * GP);
                const bf16x8 vf = __builtin_shufflevector(lo, hi, 0, 1, 2, 3, 4, 5, 6, 7);
                st.o[nt] = MFMA32(vf, pf[kt2][s], st.o[nt]);
            }
}
constexpr int LDS_WT = 98304;
DI unsigned char* wtile(unsigned char* lds, int wid) { return lds + LDS_WT + 4096 * wid; }
template <class RowF> DI void rows_to_tile(unsigned char* T, int lane, RowF rowptr) {
#pragma unroll
    for (int k = 0; k < 4; ++k) { const int rr = (lane >> 3) + 8 * k, c = lane & 7; const u32x4 v = *(const u32x4*)(rowptr(rr) + 8 * c); *(u32x4*)(T + rr * 128 + ((c ^ (rr & 7)) << 4)) = v; }
}
template <class RowF> DI void tile_to_rows(const unsigned char* T, int lane, RowF rowptr) {
#pragma unroll
    for (int k = 0; k < 4; ++k) { const int rr = (lane >> 3) + 8 * k, c = lane & 7; *(u32x4*)(rowptr(rr) + 8 * c) = *(const u32x4*)(T + rr * 128 + ((c ^ (rr & 7)) << 4)); }
}
template <class RowF, class GateF> DI void load_q(unsigned char* T, bf16x8 (&q)[4], int lane, RowF qrow, GateF gaterow) {
    u32x4 qv[4], gv[4];
#pragma unroll
    for (int k = 0; k < 4; ++k) { const int rr = (lane >> 3) + 8 * k, c = lane & 7; qv[k] = *(const u32x4*)(qrow(rr) + 8 * c); }
#pragma unroll
    for (int k = 0; k < 4; ++k) { const int rr = (lane >> 3) + 8 * k, c = lane & 7; gv[k] = *(const u32x4*)(gaterow(rr) + 8 * c); }
#pragma unroll
    for (int k = 0; k < 4; ++k) { const int rr = (lane >> 3) + 8 * k, c = lane & 7; *(u32x4*)(T + rr * 128 + ((c ^ (rr & 7)) << 4)) = qv[k]; }
    const int r32 = lane & 31, h = lane >> 5;
#pragma unroll
    for (int s = 0; s < 4; ++s) q[s] = *(const bf16x8*)(T + r32 * 128 + (((2 * s + h) ^ (r32 & 7)) << 4));
#pragma unroll
    for (int k = 0; k < 4; ++k) { const int rr = (lane >> 3) + 8 * k, c = lane & 7; *(u32x4*)(T + rr * 128 + ((c ^ (rr & 7)) << 4)) = gv[k]; }
}
template <class DstF> DI void store_gated(unsigned char* T, const f32x16 (&o)[2], float mul, int lane, DstF dstrow) {
    const int r32 = lane & 31, h = lane >> 5;
#pragma unroll
    for (int nt = 0; nt < 2; ++nt)
#pragma unroll
        for (int qd = 0; qd < 4; ++qd) {
            unsigned char* a = T + r32 * 128 + (((4 * nt + qd) ^ (r32 & 7)) << 4) + 8 * h;
            const u32x2 g = *(const u32x2*)a;
            u32x2 w; w.x = pack2(o[nt][4 * qd] * mul * bflo(g.x), o[nt][4 * qd + 1] * mul * bfhi(g.x)); w.y = pack2(o[nt][4 * qd + 2] * mul * bflo(g.y), o[nt][4 * qd + 3] * mul * bfhi(g.y));
            *(u32x2*)a = w;
        }
    tile_to_rows(T, lane, dstrow);
}

template <class SrcF, class CompF>
DI void tile_loop(unsigned char* lds, int n, int tid, SrcF src, CompF comp) {
    u16* K0 = (u16*)lds; u16* V0 = K0 + 64 * GP; u16* K1 = (u16*)(lds + 18432); u16* V1 = K1 + 64 * GP;
    u32x4 rk[2], rv[2];
    { const TileSrc s0 = src(0); tile_load(s0, rk[0], rv[0], tid); }
    { const TileSrc s1 = src(n > 1 ? 1 : 0); tile_load(s1, rk[1], rv[1], tid); }
    LBAR();
    tile_store(K0, V0, rk[0], rv[0], tid);
    LBAR();
    for (int i2 = 0; i2 < n; i2 += 2) {
#pragma unroll
        for (int j = 0; j < 2; ++j) {
            const int i = i2 + j;
            { const int nx = i + 2 < n ? i + 2 : n - 1; const TileSrc s2 = src(nx); tile_load(s2, rk[j], rv[j], tid); }
            __builtin_amdgcn_sched_barrier(0);
            if (i < n) comp(i, j ? K1 : K0, j ? V1 : V0);
            __builtin_amdgcn_sched_barrier(0);
            tile_store(j ? K0 : K1, j ? V0 : V1, rk[j ^ 1], rv[j ^ 1], tid);
            LBAR();
        }
    }
}

DI void item_swa(const Params& p, unsigned char* lds, int item) {
    const u16* Z = (const u16*)(p.ws + OFF_Z); u16* MIX = (u16*)(p.ws + OFF_MIX);
    const int tid = tid_(), wid = tid >> 6, lane = tid & 63, r32 = lane & 31;
    const int qt = item & 31, kvh = (item >> 5) & 1, b = item >> 6;
    const int tok = 64 * qt + 8 * wid + (r32 >> 2), head = 4 * kvh + (r32 & 3);
    const size_t row = (size_t)b * SEQ + tok;
    unsigned char* WT = wtile(lds, wid);
    const size_t rowb = (size_t)b * SEQ + 64 * qt + 8 * wid;
    bf16x8 q[4]; load_q(WT, q, lane, [&](int rr) { return Z + (rowb + (rr >> 2)) * LDZ0 + 64 * (4 * kvh + (rr & 3)); },
                        [&](int rr) { return Z + (rowb + (rr >> 2)) * LDZ0 + 768 + 64 * (4 * kvh + (rr & 3)); });
    AttnAcc st; attn_reset(st);
    const int kt0 = qt >= 2 ? qt - 2 : 0;
    tile_loop(lds, qt - kt0 + 1, tid,
        [&](int i) { const u16* zb = Z + ((size_t)b * SEQ + 64 * (kt0 + i)) * LDZ0; return TileSrc{zb + 512 + 64 * kvh, zb + 640 + 64 * kvh, LDZ0, LDZ0}; },
        [&](int i, const u16* Kt, const u16* Vt) {
            const int kt = kt0 + i, base = 64 * kt;
            if (kt == qt - 1) attn_compute<1>(Kt, Vt, q, st, lane, true, [&](int) { return true; });
            else attn_compute<0>(Kt, Vt, q, st, lane, true, [&](int kl) { const int s = base + kl; return s <= tok && s > tok - 128; });
        });
    const float sink = p.in[11][head];
    const float denom = st.l + ex2(sink * LOG2E - st.m);
    store_gated(WT, st.o, 1.f / denom, lane, [&](int rr) { return MIX + (rowb + (rr >> 2)) * LDMIX + 64 * (4 * kvh + (rr & 3)); });
}

DI void item_mem(const Params& p, unsigned char* lds, int item, int layer) {
    const u16* Z = (const u16*)(p.ws + OFF_Z); u16* MIX = (u16*)(p.ws + OFF_MIX);
    const u16* MKV = (const u16*)(p.ws + OFF_MKV) + (size_t)layer * 8192 * 512;
    const int ldz = layer ? LDZ1 : LDZ0, qcol = layer ? 3840 : 2304, gcol = layer ? 4096 : 2560;
    const int tid = tid_(), wid = tid >> 6, lane = tid & 63, r32 = lane & 31;
    const int tile = item & 7, head = (item >> 3) & 3, b = item >> 5;
    const int tok = 256 * tile + 32 * wid + r32;
    const size_t row = (size_t)b * SEQ + tok;
    unsigned char* WT = wtile(lds, wid);
    const size_t rowb = (size_t)b * SEQ + 256 * tile + 32 * wid;
    const u16* kb = MKV + (size_t)(b * 256) * 512 + 64 * head;
    u32x4 rk[4], rv[4];
#pragma unroll
    for (int t = 0; t < 4; ++t) { const TileSrc ts{kb + (size_t)(64 * t) * 512, kb + (size_t)(64 * t) * 512 + 256, 512, 512}; tile_load(ts, rk[t], rv[t], tid); }
    bf16x8 q[4]; load_q(WT, q, lane, [&](int rr) { return Z + (rowb + rr) * ldz + qcol + 64 * head; }, [&](int rr) { return Z + (rowb + rr) * ldz + gcol + 64 * head; });
    AttnAcc st; attn_reset(st);
    LBAR();
#pragma unroll
    for (int t = 0; t < 4; ++t) tile_store((u16*)(lds + 18432 * t), (u16*)(lds + 18432 * t) + 64 * GP, rk[t], rv[t], tid);
    LBAR();
#pragma unroll 1
    for (int t = 0; t < 4; ++t) { const u16* kt = (const u16*)(lds + 18432 * t); attn_compute<1>(kt, kt + 64 * GP, q, st, lane, true, [&](int) { return true; }); }
    store_gated(WT, st.o, 1.f / st.l, lane, [&](int rr) { return MIX + (rowb + rr) * LDMIX + 1024 + 64 * head; });
}

DI void item_nsa(const Params& p, unsigned char* lds, int item) {
    const u16* Z = (const u16*)(p.ws + OFF_Z); u16* MIX = (u16*)(p.ws + OFF_MIX);
    const u16* KC = (const u16*)(p.ws + OFF_KC); const u16* VC = (const u16*)(p.ws + OFF_VC);
    u16* Kc = (u16*)(lds + 36864); u16* Vtc = (u16*)(lds + 55296);
    float* pc4 = (float*)(lds + 73728); float* pl = (float*)(lds + 82432);
    unsigned* selm = (unsigned*)(lds + 91136); unsigned* umw = (unsigned*)(lds + 91392);
    const int tid = tid_(), wid = tid >> 6, lane = tid & 63, r32 = lane & 31, h = lane >> 5;
    const int qt = 31 - (item >> 6), kvh = item & 1, b = (item >> 1) & 31;
    const int ttl = 8 * wid + (r32 >> 2);
    const int tok = 64 * qt + ttl, head = 4 * kvh + (r32 & 3);
    const size_t row = (size_t)b * SEQ + tok;
    const u16* zrow = Z + row * LDZ1;
    unsigned char* WT = wtile(lds, wid);
    const size_t rowb = (size_t)b * SEQ + 64 * qt + 8 * wid;
    bf16x8 q[4]; load_q(WT, q, lane, [&](int rr) { return Z + (rowb + (rr >> 2)) * LDZ1 + 2048 + 64 * (4 * kvh + (rr & 3)); },
                        [&](int rr) { return Z + (rowb + (rr >> 2)) * LDZ1 + 3328 + 64 * (4 * kvh + (rr & 3)); });
    float gcmp, gsel, gwin;
    { const u16* gp = zrow + 4352 + 3 * head; gcmp = bf2f(gp[0]); gsel = bf2f(gp[1]); gwin = bf2f(gp[2]); }
    f32x16 osum[2];
    {
        const u16* kcb = KC + ((size_t)(b * 128) * 2 + kvh) * 64; const u16* vcb = VC + ((size_t)(b * 128) * 2 + kvh) * 64;
        u32x4 ck[2], cv[2];
#pragma unroll
        for (int i = 0; i < 2; ++i) {
            ck[i] = *(const u32x4*)(kcb + (size_t)((tid >> 3) + 64 * i) * 128 + (tid & 7) * 8);
            cv[i] = *(const u32x4*)(vcb + (size_t)((tid >> 3) + 64 * i) * 128 + (tid & 7) * 8);
        }
        __syncthreads();
#pragma unroll
        for (int i = 0; i < 2; ++i) {
            const int key = (tid >> 3) + 64 * i;
            *(u32x4*)(Kc + key * GP + (tid & 7) * 8) = ck[i];
            *(u32x4*)(Vtc + key * GP + (tid & 7) * 8) = cv[i];
        }
    }
    __syncthreads();
    {
        f32x16 X[4];
#pragma unroll
        for (int k4 = 0; k4 < 4; ++k4) {
#pragma unroll
            for (int i = 0; i < 16; ++i) X[k4][i] = 0.f;
#pragma unroll
            for (int s = 0; s < 4; ++s) { const bf16x8 kf = *(const bf16x8*)(Kc + (32 * k4 + r32) * GP + 16 * s + 8 * h); X[k4] = MFMA32(kf, q[s], X[k4]); }
        }
        const int nmax = tok >= 31 ? ((tok - 31) >> 4) : -1;
        float mx = -1e30f;
#pragma unroll
        for (int k4 = 0; k4 < 4; ++k4)
#pragma unroll
            for (int reg = 0; reg < 16; ++reg) { const int n = 32 * k4 + (reg & 3) + 8 * (reg >> 2) + 4 * h; float t = X[k4][reg] * SC_LOG2; t = n <= nmax ? t : -1e30f; X[k4][reg] = t; mx = fmaxf(mx, t); }
        mx = xor32_max(mx);
        float rsum = 0.f;
#pragma unroll
        for (int k4 = 0; k4 < 4; ++k4)
#pragma unroll
            for (int reg = 0; reg < 16; ++reg) { const float t = X[k4][reg]; const float pv = t > -1e29f ? ex2(t - mx) : 0.f; X[k4][reg] = pv; rsum += pv; }
        rsum = xor32_sum(rsum);
        const float inv = rsum > 0.f ? 1.f / rsum : 0.f;
#pragma unroll
        for (int k4 = 0; k4 < 4; ++k4)
#pragma unroll
            for (int reg = 0; reg < 16; ++reg) X[k4][reg] *= inv;
#pragma unroll
        for (int k4 = 0; k4 < 4; ++k4)
#pragma unroll
            for (int q4 = 0; q4 < 4; ++q4) {
                float s4 = (X[k4][4 * q4] + X[k4][4 * q4 + 1]) + (X[k4][4 * q4 + 2] + X[k4][4 * q4 + 3]);
                float lt = X[k4][4 * q4 + 3];
                s4 = quad_sum(s4); lt = quad_sum(lt);
                if ((r32 & 3) == 0) { const int j = 8 * k4 + 2 * q4 + h; pc4[ttl * 33 + j] = s4; pl[ttl * 33 + j] = lt; }
            }
        f32x16 o[2];
#pragma unroll
        for (int i = 0; i < 16; ++i) { o[0][i] = 0.f; o[1][i] = 0.f; }
#pragma unroll
        for (int k4 = 0; k4 < 4; ++k4)
#pragma unroll
            for (int s = 0; s < 2; ++s) {
                u32x4 w; w.x = pack2(X[k4][8 * s], X[k4][8 * s + 1]); w.y = pack2(X[k4][8 * s + 2], X[k4][8 * s + 3]);
                w.z = pack2(X[k4][8 * s + 4], X[k4][8 * s + 5]); w.w = pack2(X[k4][8 * s + 6], X[k4][8 * s + 7]);
                const bf16x8 pf = __builtin_bit_cast(bf16x8, w);
#pragma unroll
                for (int nt = 0; nt < 2; ++nt) {
                    const u16* vp = Vtc + (32 * k4 + 16 * s + 4 * h + ((lane & 15) >> 2)) * GP + 32 * nt + 16 * ((lane >> 4) & 1) + 4 * (lane & 3);
                    const s16x4 lo = tr_read(vp), hi = tr_read(vp + 8 * GP);
                    const bf16x8 vf = __builtin_shufflevector(lo, hi, 0, 1, 2, 3, 4, 5, 6, 7);
                    o[nt] = MFMA32(vf, pf, o[nt]);
                }
            }
#pragma unroll
        for (int i = 0; i < 16; ++i) { osum[0][i] = o[0][i] * gcmp; osum[1][i] = o[1][i] * gcmp; }
    }
    __syncthreads();
    if (tid < 64) {
        const int cur = qt;
        unsigned mask = 1u | (1u << cur);
        const int npick = 2;
        if (cur >= 2) {
            int p1 = -1, p2 = -1; float b1 = -1.f, b2 = -1.f;
            for (int j = 1; j < cur; ++j) {
                const float v = pc4[tid * 33 + j] + pl[tid * 33 + j - 1];
                if (v > b1) { b2 = b1; p2 = p1; b1 = v; p1 = j; }
                else if (v > b2) { b2 = v; p2 = j; }
            }
            if (p1 >= 0) mask |= 1u << p1;
            if (p2 >= 0) mask |= 1u << p2;
        }
        selm[tid] = mask;
        unsigned um = mask;
#pragma unroll
        for (int o = 1; o < 64; o <<= 1) um |= (unsigned)__shfl_xor((int)um, o);
        if (tid == 0) umw[0] = um;
    }
    __syncthreads();
    const unsigned sm = selm[ttl];
    unsigned um = umw[0];
    {
        AttnAcc st; attn_reset(st);
        const int ntile = __builtin_popcount(um);
        unsigned rem_src = um, rem_cmp = um; int kt_src = 0;
        tile_loop(lds, ntile, tid,
            [&](int) { if (rem_src) { kt_src = __builtin_ctz(rem_src); rem_src &= rem_src - 1; } const int kt = kt_src; const u16* zb = Z + ((size_t)b * SEQ + 64 * kt) * LDZ1; return TileSrc{zb + 2816 + 64 * kvh, zb + 2944 + 64 * kvh, LDZ1, LDZ1}; },
            [&](int, const u16* Kt, const u16* Vt) {
                const int ktc = __builtin_ctz(rem_cmp); rem_cmp &= rem_cmp - 1;
                const int kt = ktc, base = 64 * kt; const bool on = (sm >> kt) & 1u;
                if (__any(on)) {
                    if (kt < qt) attn_compute<2>(Kt, Vt, q, st, lane, on, [&](int) { return true; });
                    else attn_compute<0>(Kt, Vt, q, st, lane, true, [&](int kl) { return on && (base + kl <= tok); });
                }
            });
        const float mul = gsel / st.l;
#pragma unroll
        for (int i = 0; i < 16; ++i) { osum[0][i] += st.o[0][i] * mul; osum[1][i] += st.o[1][i] * mul; }
    }
    {
        AttnAcc st; attn_reset(st);
        const int kt0 = qt >= 8 ? qt - 8 : 0;
        tile_loop(lds, qt - kt0 + 1, tid,
            [&](int i) { const u16* zb = Z + ((size_t)b * SEQ + 64 * (kt0 + i)) * LDZ1; return TileSrc{zb + 3072 + 64 * kvh, zb + 3200 + 64 * kvh, LDZ1, LDZ1}; },
            [&](int i, const u16* Kt, const u16* Vt) {
                const int kt = kt0 + i, base = 64 * kt;
                if (kt < qt && kt > qt - 8) attn_compute<1>(Kt, Vt, q, st, lane, true, [&](int) { return true; });
                else attn_compute<0>(Kt, Vt, q, st, lane, true, [&](int kl) { const int s = base + kl; return s <= tok && s > tok - 512; });
            });
        const float mul = gwin / st.l;
#pragma unroll
        for (int i = 0; i < 16; ++i) { osum[0][i] += st.o[0][i] * mul; osum[1][i] += st.o[1][i] * mul; }
    }
    store_gated(WT, osum, 1.f, lane, [&](int rr) { return MIX + (rowb + (rr >> 2)) * LDMIX + 512 + 64 * (4 * kvh + (rr & 3)); });
}

DI void item_rglru(const Params& p, unsigned char* lds, int item) {
    const u16* Z = (const u16*)(p.ws + OFF_Z); u16* MIX = (u16*)(p.ws + OFF_MIX);
    float* Xs = (float*)lds;
    float* XC = (float*)(lds + 17152);
    u16* XCb = (u16*)(lds + 34560);
    u16* WrT = (u16*)(lds + 43776); u16* WiT = (u16*)(lds + 52992);
    float* Aa = (float*)(lds + 62208); float* Uu = (float*)(lds + 78592);
    u16* Gs = (u16*)(lds + 94976);
    float* segA = (float*)(lds + 103168); float* segB = (float*)(lds + 105216);
    float* carry = (float*)(lds + 107264);
    const int tid = tid_(), wid = tid >> 6, lane = tid & 63, fr = lane & 15, fq = lane >> 4;
    const int hb = item & 7, b = item >> 3;
    __syncthreads();
    {
        const float* wr = p.in[14] + (size_t)hb * 4096; const float* wi = p.in[16] + (size_t)hb * 4096;
#pragma unroll
        for (int e = 0; e < 8; ++e) { const int idx = tid + 512 * e, i = idx >> 6, j = idx & 63; WrT[j * GP + i] = f2bf(wr[idx]); WiT[j * GP + i] = f2bf(wi[idx]); }
        if (tid < 192) Xs[tid] = 0.f;
        if (tid < 64) carry[tid] = 0.f;
    }
    const int ct = tid >> 3, cc8 = (tid & 7) * 8;
    float cw[4][8], cb[8];
#pragma unroll
    for (int e = 0; e < 8; ++e) {
        cb[e] = p.in[13][64 * hb + cc8 + e];
#pragma unroll
        for (int j = 0; j < 4; ++j) cw[j][e] = p.in[12][j * 512 + 64 * hb + cc8 + e];
    }
    const int jt = wid & 3, tpair = wid >> 2;
    float sp[4], br[4], bi[4];
#pragma unroll
    for (int r = 0; r < 4; ++r) {
        const int c = 64 * hb + 16 * jt + 4 * fq + r;
        const float lam = p.in[18][c];
        sp[r] = log1pf(expf(-lam)); br[r] = p.in[15][c]; bi[r] = p.in[17][c];
    }
    const size_t zrow0 = (size_t)b * SEQ;
    u32x4 rx = *(const u32x4*)(Z + (zrow0 + ct) * LDZ0 + 1280 + 64 * hb + cc8);
    u32x4 rg = *(const u32x4*)(Z + (zrow0 + ct) * LDZ0 + 1792 + 64 * hb + cc8);
    for (int c = 0; c < 32; ++c) {
        {
            float* xr = Xs + (3 + ct) * 64 + cc8;
            *(f32x4*)xr = (f32x4){bflo(rx.x), bfhi(rx.x), bflo(rx.y), bfhi(rx.y)};
            *(f32x4*)(xr + 4) = (f32x4){bflo(rx.z), bfhi(rx.z), bflo(rx.w), bfhi(rx.w)};
            *(u32x4*)(Gs + ct * 64 + cc8) = rg;
        }
        LBAR();
        {
            const int cn = c + 1 < 32 ? c + 1 : 31;
            rx = *(const u32x4*)(Z + (zrow0 + 64 * cn + ct) * LDZ0 + 1280 + 64 * hb + cc8);
            rg = *(const u32x4*)(Z + (zrow0 + 64 * cn + ct) * LDZ0 + 1792 + 64 * hb + cc8);
        }
        __builtin_amdgcn_sched_barrier(0);
        {
            float xc[8];
#pragma unroll
            for (int e = 0; e < 8; ++e) xc[e] = cb[e];
#pragma unroll
            for (int j = 0; j < 4; ++j) {
                const f32x4 a = *(const f32x4*)(Xs + (ct + j) * 64 + cc8), bb = *(const f32x4*)(Xs + (ct + j) * 64 + cc8 + 4);
#pragma unroll
                for (int e = 0; e < 4; ++e) { xc[e] += cw[j][e] * a[e]; xc[4 + e] += cw[j][4 + e] * bb[e]; }
            }
            *(f32x4*)(XC + ct * 68 + cc8) = (f32x4){xc[0], xc[1], xc[2], xc[3]};
            *(f32x4*)(XC + ct * 68 + cc8 + 4) = (f32x4){xc[4], xc[5], xc[6], xc[7]};
            u32x4 w; w.x = pack2(xc[0], xc[1]); w.y = pack2(xc[2], xc[3]); w.z = pack2(xc[4], xc[5]); w.w = pack2(xc[6], xc[7]);
            *(u32x4*)(XCb + ct * GP + cc8) = w;
        }
        LBAR();
        {
#pragma unroll
            for (int ts = 0; ts < 2; ++ts) {
                const int tt = 2 * tpair + ts;
                f32x4 accr = {0.f, 0.f, 0.f, 0.f}, acci = {0.f, 0.f, 0.f, 0.f};
#pragma unroll
                for (int ks = 0; ks < 2; ++ks) {
                    const bf16x8 ar = *(const bf16x8*)(WrT + (16 * jt + fr) * GP + 32 * ks + 8 * fq);
                    const bf16x8 ai = *(const bf16x8*)(WiT + (16 * jt + fr) * GP + 32 * ks + 8 * fq);
                    const bf16x8 bx = *(const bf16x8*)(XCb + (16 * tt + fr) * GP + 32 * ks + 8 * fq);
                    accr = MFMA16(ar, bx, accr); acci = MFMA16(ai, bx, acci);
                }
                const int t = 16 * tt + fr;
                const f32x4 xc4 = *(const f32x4*)(XC + t * 68 + 16 * jt + 4 * fq);
                f32x4 av, uv;
#pragma unroll
                for (int r = 0; r < 4; ++r) {
                    const float rgate = sigmoidf_(accr[r] + br[r]), igate = sigmoidf_(acci[r] + bi[r]);
                    const float la = -8.f * rgate * sp[r];
                    av[r] = __expf(la); uv[r] = __builtin_amdgcn_sqrtf(fmaxf(1.f - av[r] * av[r], 0.f)) * igate * xc4[r];
                }
                *(f32x4*)(Aa + t * 64 + 16 * jt + 4 * fq) = av; *(f32x4*)(Uu + t * 64 + 16 * jt + 4 * fq) = uv;
            }
            if (tid < 192) Xs[tid] = Xs[64 * 64 + tid];
        }
        LBAR();
        const int ch = tid & 63, seg = tid >> 6;
        float av8[8], uv8[8];
        {
            float A = 1.f, B = 0.f;
#pragma unroll
            for (int i = 0; i < 8; ++i) { av8[i] = Aa[(8 * seg + i) * 64 + ch]; uv8[i] = Uu[(8 * seg + i) * 64 + ch]; B = av8[i] * B + uv8[i]; A *= av8[i]; }
            segA[seg * 64 + ch] = A; segB[seg * 64 + ch] = B;
        }
        LBAR();
        {
            float hst = carry[(c & 1) * 64 + ch];
#pragma unroll
            for (int s = 0; s < 7; ++s) if (s < seg) hst = segA[s * 64 + ch] * hst + segB[s * 64 + ch];
#pragma unroll
            for (int i = 0; i < 8; ++i) {
                hst = av8[i] * hst + uv8[i];
                const int t = 8 * seg + i;
                MIX[(zrow0 + 64 * c + t) * LDMIX + 512 + 64 * hb + ch] = f2bf(hst * bf2f(Gs[t * 64 + ch]));
            }
            if (seg == 7) carry[((c + 1) & 1) * 64 + ch] = hst;
        }
        LBAR();
    }
}

DI void item_hgrn(const Params& p, unsigned char* lds, int item) {
    const u16* __restrict__ Z = (const u16*)(p.ws + OFF_Z); u16* __restrict__ MIX = (u16*)(p.ws + OFF_MIX);
    u16* Qs = (u16*)lds;
    u16* Ks = (u16*)(lds + 17408);
    u16* Vr = (u16*)(lds + 34816);
    u16* KhT = (u16*)(lds + 52224);
    u16* VT = (u16*)(lds + 70656);
    u16* As = (u16*)(lds + 89088);
    u16* ST = (u16*)(lds + 98304);
    float* qsum = (float*)(lds + 133120);
    float* dec = (float*)(lds + 135168);
    float* ssq = (float*)(lds + 135680);
    const int tid = tid_(), wid = tid >> 6, lane = tid & 63, fr = lane & 15, fq = lane >> 4;
    const int head = item & 3, b = item >> 2;
    const int d = tid & 127, qt = tid >> 7;
    const int lt = tid >> 3, lc = (tid & 7) * 16;
    __syncthreads();
    for (int i = tid; i < 128 * GP2 / 2; i += NTHR) ((unsigned*)ST)[i] = 0u;
    f32x4 sacc[8];
#pragma unroll
    for (int v = 0; v < 8; ++v) sacc[v] = (f32x4){0.f, 0.f, 0.f, 0.f};
    float og[4];
#pragma unroll
    for (int r = 0; r < 4; ++r) og[r] = p.in[22][16 * wid + 4 * fq + r];
    const size_t zrow0 = (size_t)b * SEQ;
    const int gcol = 1536 + 128 * head + 16 * wid + 4 * fq;
    u32x4 rq[2], rg[2], rv[2]; u32x2 gn[4];
    {
        const u16* zp = Z + (zrow0 + lt) * LDZ1 + 128 * head + lc;
        rq[0] = *(const u32x4*)zp; rq[1] = *(const u32x4*)(zp + 8);
        rg[0] = *(const u32x4*)(zp + 512); rg[1] = *(const u32x4*)(zp + 520);
        rv[0] = *(const u32x4*)(zp + 1024); rv[1] = *(const u32x4*)(zp + 1032);
#pragma unroll
        for (int tt = 0; tt < 4; ++tt) gn[tt] = *(const u32x2*)(Z + (zrow0 + 16 * tt + fr) * LDZ1 + gcol);
    }
    for (int c = 0; c < 32; ++c) {
        u32x2 gc[4];
        {
            *(u32x4*)(Qs + lt * GP2 + lc) = rq[0]; *(u32x4*)(Qs + lt * GP2 + lc + 8) = rq[1];
            *(u32x4*)(Ks + lt * GP2 + lc) = rg[0]; *(u32x4*)(Ks + lt * GP2 + lc + 8) = rg[1];
            *(u32x4*)(Vr + lt * GP2 + lc) = rv[0]; *(u32x4*)(Vr + lt * GP2 + lc + 8) = rv[1];
#pragma unroll
            for (int tt = 0; tt < 4; ++tt) gc[tt] = gn[tt];
        }
        LBAR();
        {
            const int cn = c + 1 < 32 ? c + 1 : 31;
            const u16* zp = Z + (zrow0 + 64 * cn + lt) * LDZ1 + 128 * head + lc;
            rq[0] = *(const u32x4*)zp; rq[1] = *(const u32x4*)(zp + 8);
            rg[0] = *(const u32x4*)(zp + 512); rg[1] = *(const u32x4*)(zp + 520);
            rv[0] = *(const u32x4*)(zp + 1024); rv[1] = *(const u32x4*)(zp + 1032);
#pragma unroll
            for (int tt = 0; tt < 4; ++tt) gn[tt] = *(const u32x2*)(Z + (zrow0 + 64 * cn + 16 * tt + fr) * LDZ1 + gcol);
        }
        __builtin_amdgcn_sched_barrier(0);
        float bl[16], gv[16];
        {
            float run = 0.f;
#pragma unroll
            for (int i = 0; i < 16; ++i) { gv[i] = bf2f(Ks[(16 * qt + i) * GP2 + d]); run += gv[i]; bl[i] = run; }
            qsum[qt * 128 + d] = run;
        }
        LBAR();
        {
            float off = 0.f, tot = 0.f;
#pragma unroll
            for (int qq = 0; qq < 4; ++qq) { const float s = qsum[qq * 128 + d]; tot += s; if (qq < qt) off += s; }
            unsigned khw[8], vw[8];
#pragma unroll
            for (int i2 = 0; i2 < 8; ++i2) {
                float kh[2], vv[2];
#pragma unroll
                for (int e = 0; e < 2; ++e) {
                    const int i = 2 * i2 + e;
                    const float bb = off + bl[i];
                    const float kk = 1.f - __expf(gv[i]);
                    const float qv = bf2f(Qs[(16 * qt + i) * GP2 + d]);
                    vv[e] = bf2f(Vr[(16 * qt + i) * GP2 + d]);
                    Qs[(16 * qt + i) * GP2 + d] = f2bf(qv * __expf(bb));
                    Ks[(16 * qt + i) * GP2 + d] = f2bf(kk * __expf(fminf(-bb, 80.f)));
                    kh[e] = kk * __expf(tot - bb);
                }
                khw[i2] = pack2(kh[0], kh[1]); vw[i2] = pack2(vv[0], vv[1]);
            }
            *(u32x4*)(KhT + d * GP + 16 * qt) = (u32x4){khw[0], khw[1], khw[2], khw[3]};
            *(u32x4*)(KhT + d * GP + 16 * qt + 8) = (u32x4){khw[4], khw[5], khw[6], khw[7]};
            *(u32x4*)(VT + d * GP + 16 * qt) = (u32x4){vw[0], vw[1], vw[2], vw[3]};
            *(u32x4*)(VT + d * GP + 16 * qt + 8) = (u32x4){vw[4], vw[5], vw[6], vw[7]};
            if (qt == 0) dec[d] = __expf(tot);
        }
        LBAR();
        {
            const int st = wid >> 1;
#pragma unroll
            for (int ts = 0; ts < 2; ++ts) {
                const int tt = 2 * (wid & 1) + ts;
                f32x4 acc = {0.f, 0.f, 0.f, 0.f};
                if (st <= tt) {
#pragma unroll
                    for (int ks = 0; ks < 4; ++ks) {
                        const bf16x8 a = *(const bf16x8*)(Ks + (16 * st + fr) * GP2 + 32 * ks + 8 * fq);
                        const bf16x8 bq = *(const bf16x8*)(Qs + (16 * tt + fr) * GP2 + 32 * ks + 8 * fq);
                        acc = MFMA16(a, bq, acc);
                    }
                }
                const int t = 16 * tt + fr, s0 = 16 * st + 4 * fq;
                float a4[4];
#pragma unroll
                for (int r = 0; r < 4; ++r) a4[r] = (s0 + r <= t) ? acc[r] : 0.f;
                u32x2 w; w.x = pack2(a4[0], a4[1]); w.y = pack2(a4[2], a4[3]);
                *(u32x2*)(As + t * GP + s0) = w;
            }
        }
        LBAR();
        f32x4 oacc[4];
        {
#pragma unroll
            for (int tt = 0; tt < 4; ++tt) oacc[tt] = (f32x4){0.f, 0.f, 0.f, 0.f};
#pragma unroll
            for (int ks = 0; ks < 4; ++ks) {
                const bf16x8 a = *(const bf16x8*)(ST + (16 * wid + fr) * GP2 + 32 * ks + 8 * fq);
#pragma unroll
                for (int tt = 0; tt < 4; ++tt) { const bf16x8 bq = *(const bf16x8*)(Qs + (16 * tt + fr) * GP2 + 32 * ks + 8 * fq); oacc[tt] = MFMA16(a, bq, oacc[tt]); }
            }
#pragma unroll
            for (int ks = 0; ks < 2; ++ks) {
                const bf16x8 a = *(const bf16x8*)(VT + (16 * wid + fr) * GP + 32 * ks + 8 * fq);
#pragma unroll
                for (int tt = 0; tt < 4; ++tt) { const bf16x8 ba = *(const bf16x8*)(As + (16 * tt + fr) * GP + 32 * ks + 8 * fq); oacc[tt] = MFMA16(a, ba, oacc[tt]); }
            }
#pragma unroll
            for (int tt = 0; tt < 4; ++tt) {
                float s = oacc[tt][0] * oacc[tt][0] + oacc[tt][1] * oacc[tt][1] + oacc[tt][2] * oacc[tt][2] + oacc[tt][3] * oacc[tt][3];
                s = xor32_sum(xor16_sum(s));
                if (fq == 0) ssq[wid * 64 + 16 * tt + fr] = s;
            }
        }
        LBAR();
        {
#pragma unroll
            for (int tt = 0; tt < 4; ++tt) {
                const int t = 16 * tt + fr;
                float tot = 0.f;
#pragma unroll
                for (int w = 0; w < 8; ++w) tot += ssq[w * 64 + t];
                const float inv = rsqrtf(tot * (1.f / 128.f) + EPS);
                const size_t row = zrow0 + 64 * c + t;
                const u32x2 g = gc[tt];
                u32x2 w; w.x = pack2(oacc[tt][0] * inv * og[0] * bflo(g.x), oacc[tt][1] * inv * og[1] * bfhi(g.x));
                w.y = pack2(oacc[tt][2] * inv * og[2] * bflo(g.y), oacc[tt][3] * inv * og[3] * bfhi(g.y));
                *(u32x2*)(MIX + row * LDMIX + 128 * head + 16 * wid + 4 * fq) = w;
            }
            const f32x4 d4 = *(const f32x4*)(dec + 16 * wid + 4 * fq);
#pragma unroll
            for (int v = 0; v < 8; ++v) sacc[v] = sacc[v] * d4;
#pragma unroll
            for (int ks = 0; ks < 2; ++ks) {
                const bf16x8 a = *(const bf16x8*)(KhT + (16 * wid + fr) * GP + 32 * ks + 8 * fq);
#pragma unroll
                for (int v = 0; v < 8; ++v) { const bf16x8 bv = *(const bf16x8*)(VT + (16 * v + fr) * GP + 32 * ks + 8 * fq); sacc[v] = MFMA16(a, bv, sacc[v]); }
            }
#pragma unroll
            for (int v = 0; v < 8; ++v) { u32x2 w; w.x = pack2(sacc[v][0], sacc[v][1]); w.y = pack2(sacc[v][2], sacc[v][3]); *(u32x2*)(ST + (16 * v + fr) * GP2 + 16 * wid + 4 * fq) = w; }
        }
        LBAR();
    }
}

DI void phase_inproj(const Params& p, unsigned char* lds, int layer) {
    unsigned char* ws = p.ws;
    PG8_LAS unsigned char* l3 = (PG8_LAS unsigned char*)lds;
    const int NT = layer ? 18 : 11;
    EpiZ e; e.Z = (u16*)(ws + OFF_Z); e.ldz = layer ? LDZ1 : LDZ0; e.rs = (const float*)(ws + (layer ? OFF_RSP : OFF_RS0)); e.rs4 = (layer != 0); e.layer = layer; e.p = &p;
    e.cs = (const float*)(ws + OFF_COS); e.sn = (const float*)(ws + OFF_SIN); e.tr = lds + LDS_TR + 2048 * (tid_() >> 6);
    pg8::Gemm g{(const u16*)(ws + OFF_XB), (const u16*)(ws + (layer ? OFF_WT1 : OFF_WT0)), DM};
    pg8::SchedIn S{NT, (int)(gridDim.x >> 3), (int)(blockIdx.x >> 3), (int)(blockIdx.x & 7)};
    pg8::gemm_phase<EpiZ, pg8::SchedIn, true>(l3, g, S, e);
    if (layer == 0) {
        for (int u = blockIdx.x; u < 128; u += gridDim.x) {
            const int l = u >> 6, pm = (u >> 1) & 31, pn = u & 1;
            EpiZ em; em.Z = (u16*)(ws + OFF_MKV) + (size_t)l * 8192 * 512; em.ldz = 512; em.rs = (const float*)(ws + OFF_RSM); em.layer = 2 + l; em.p = &p; em.cs = e.cs; em.sn = e.sn; em.tr = e.tr; em.rs4 = false;
            pg8::Gemm gm{(const u16*)(ws + OFF_MEMB), (const u16*)(ws + OFF_WM) + (size_t)l * 512 * 1024, DM};
            pg8::SchedOne S1{pm, pn, true};
            pg8::gemm_phase<EpiZ, pg8::SchedOne, false>(l3, gm, S1, em);
        }
        if (gridDim.x > 128) { if (blockIdx.x >= 128) prep_layer1(p, lds, blockIdx.x - 128, gridDim.x - 128); }
        else prep_layer1(p, lds, blockIdx.x, gridDim.x);
    }
}

DI void phase_outproj(const Params& p, unsigned char* lds, int layer) {
    unsigned char* ws = p.ws;
    PG8_LAS unsigned char* l3 = (PG8_LAS unsigned char*)lds;
    pg8::Gemm g{(const u16*)(ws + OFF_MIX), (const u16*)(ws + (layer ? OFF_WO1 : OFF_WO0)), LDMIX};
    const int tid = tid_();
    if (layer == 0) {
        EpiOut0 e; e.x = p.in[0]; e.out = p.out; e.xb = (u16*)(ws + OFF_XB); e.red = (float*)(lds + LDS_RED); e.tr = lds + LDS_TR + 2048 * (tid >> 6);
        e.rsp = (float*)(ws + OFF_RSP); e.par = 0; e.ppm = -1; e.ppn = 0;
        pg8::SchedOutX S{(int)(gridDim.x >> 3), (int)(blockIdx.x >> 3), (int)(blockIdx.x & 7)};
        pg8::gemm_phase<EpiOut0, pg8::SchedOutX, true>(l3, g, S, e);
        __syncthreads();
        { const int lane = tid & 63, wid = tid >> 6; e.flush(wid >> 2, wid & 3, lane & 15, lane >> 4); }
        __syncthreads();
    }
    if (layer == 1) {
        EpiOut1 e; e.out = p.out; e.xb = (const u16*)(ws + OFF_XB); e.tr = lds + LDS_TR + 2048 * (tid >> 6);
        pg8::SchedOutX S{(int)(gridDim.x >> 3), (int)(blockIdx.x >> 3), (int)(blockIdx.x & 7)};
        pg8::gemm_phase<EpiOut1, pg8::SchedOutX, true>(l3, g, S, e);
    }
}

DI void compress_unit(const Params& p, unsigned char* lds, int u) {
    unsigned char* ws = p.ws;
    const int kv = u & 1, pm = u >> 1;
    EpiCmp e; e.bias = (const float*)(ws + OFF_BIAS) + 128 * kv; e.w2 = kv ? p.in[32] : p.in[30]; e.gain = p.in[24]; e.dst = (u16*)(ws + (kv ? OFF_VC : OFF_KC)); e.isk = (kv == 0);
    e.cs = (const float*)(ws + OFF_COS); e.sn = (const float*)(ws + OFF_SIN);
    const u16* Zc = (const u16*)(ws + OFF_Z) + (kv ? 2688 : 2560);
    gemm_unit<EpiCmp, true>(lds, Zc, LDZ1, 0, (const u16*)(ws + (kv ? OFF_W1V : OFF_W1K)), 2048, 32, pm, 0, e);
}

DI void phase_mix0(const Params& p, unsigned char* lds) {
    for (int it = blockIdx.x; it < 256; it += gridDim.x) item_rglru(p, lds, it);
    for (int it = blockIdx.x; it < 2048; it += gridDim.x) item_swa(p, lds, it);
    for (int it = blockIdx.x; it < 1024; it += gridDim.x) item_mem(p, lds, it, 0);
}

__shared__ int s_ticket;
DI void phase_mix1(const Params& p, unsigned char* lds, int ci) {
    unsigned* ctr = (unsigned*)(p.ws + OFF_CTR) + ci;
    bool cmp_ready = false;
    unsigned nxt = 0;
    if (threadIdx.x == 0) nxt = atomicAdd(ctr, 1u);
    for (;;) {
        __syncthreads();
        if (threadIdx.x == 0) { s_ticket = (int)nxt; nxt = atomicAdd(ctr, 1u); }
        __syncthreads();
        const int tk = s_ticket;
        if (tk >= 128 + 64 + 1024 + 2048) break;
        if (tk < 128) item_hgrn(p, lds, tk);
        else if (tk < 192) {
            compress_unit(p, lds, tk - 128);
            __threadfence(); __syncthreads();
            if (threadIdx.x == 0) atomicAdd(ctr + 8, 1u);
        }
        else if (tk < 192 + 1024) item_mem(p, lds, tk - 192, 1);
        else {
            if (!cmp_ready) {
                if (threadIdx.x == 0) { while (__hip_atomic_load(ctr + 8, __ATOMIC_RELAXED, __HIP_MEMORY_SCOPE_AGENT) < 64u) __builtin_amdgcn_s_sleep(8); }
                __syncthreads(); __threadfence(); cmp_ready = true;
            }
            item_nsa(p, lds, tk - 192 - 1024);
        }
    }
}


DI void gbar(unsigned* bar, unsigned k) {
    __syncthreads();
    if (threadIdx.x == 0) {
        __builtin_amdgcn_fence(__ATOMIC_RELEASE, "agent"); asm volatile("s_waitcnt vmcnt(0)" ::: "memory");
        atomicAdd(bar, 1u);
        const unsigned target = k * gridDim.x;
        while (__hip_atomic_load(bar, __ATOMIC_RELAXED, __HIP_MEMORY_SCOPE_AGENT) < target) __builtin_amdgcn_s_sleep(2);
        __builtin_amdgcn_fence(__ATOMIC_ACQUIRE, "agent"); asm volatile("s_waitcnt vmcnt(0)" ::: "memory");
    }
    __syncthreads();
}

constexpr int NPHASE = 8;
__global__ void __launch_bounds__(NTHR) mega(Params p) {
    extern __shared__ __attribute__((aligned(16))) unsigned char lds[];
    cg::grid_group grid = cg::this_grid();
#ifndef PROBE_MASK
#define PROBE_MASK 0
#endif
    unsigned* bar = (unsigned*)(p.ws + OFF_BAR); unsigned nbar = 0;
#define PH(k, call0, call1) if (p.ph_lo <= (k) && (k) < p.ph_hi) { call0; if ((PROBE_MASK >> (k)) & 1) { grid.sync(); call1; } if ((k) + 1 < p.ph_hi) { if ((k) == 0) grid.sync(); else gbar(bar, ++nbar); } }
    PH(0, phase_prep(p, lds), phase_prep(p, lds))
    PH(1, phase_inproj(p, lds, 0), phase_inproj(p, lds, 0))
    PH(2, phase_mix0(p, lds), phase_mix0(p, lds))
    PH(3, phase_outproj(p, lds, 0), phase_outproj(p, lds, 0))
    PH(4, phase_inproj(p, lds, 1), phase_inproj(p, lds, 1))
    PH(6, phase_mix1(p, lds, 0), phase_mix1(p, lds, 1))
    PH(7, phase_outproj(p, lds, 1), phase_outproj(p, lds, 1))
#undef PH
}

extern "C" void kernel_launch(void* const* d_in, const int* in_sizes, int n_in, void* d_out, int out_size, void* d_ws, size_t ws_size, hipStream_t stream) {
    static int grid = 0;
    if (grid == 0) {
        if (n_in != 33 || ws_size < WS_END) { fprintf(stderr, "kernel_launch: unexpected n_in %d / ws_size %zu (need %zu)\n", n_in, ws_size, (size_t)WS_END); grid = -1; return; }
        int dev = 0, cus = 0, per_cu = 0;
        hipGetDevice(&dev);
        hipDeviceGetAttribute(&cus, hipDeviceAttributeMultiprocessorCount, dev);
        if (hipFuncSetAttribute((const void*)mega, hipFuncAttributeMaxDynamicSharedMemorySize, LDS_BYTES) != hipSuccess) { fprintf(stderr, "kernel_launch: hipFuncSetAttribute failed\n"); grid = -1; return; }
        hipOccupancyMaxActiveBlocksPerMultiprocessor(&per_cu, (const void*)mega, NTHR, LDS_BYTES);
        if (per_cu < 1) { fprintf(stderr, "kernel_launch: occupancy query says %d blocks per CU\n", per_cu); per_cu = 1; }
        (void)hipGetLastError();
        grid = cus;
        if (grid % 8) grid -= grid % 8;
    }
    if (grid < 0) return;
    Params p{};
    for (int i = 0; i < 33; ++i) p.in[i] = (const float*)d_in[i];
    p.out = (float*)d_out; p.ws = (unsigned char*)d_ws;
#if ONE_LAUNCH
    p.ph_lo = 0; p.ph_hi = NPHASE;
    void* args[] = {&p};
    hipError_t e = hipLaunchCooperativeKernel((const void*)mega, dim3(grid), dim3(NTHR), args, LDS_BYTES, stream);
    if (e != hipSuccess) fprintf(stderr, "cooperative launch failed: %s (grid %d)\n", hipGetErrorString(e), grid);
#else
    for (int ph = 0; ph < NPHASE; ++ph) {
        p.ph_lo = ph; p.ph_hi = ph + 1;
        hipLaunchKernelGGL(mega, dim3(grid), dim3(NTHR), LDS_BYTES, stream, p);
    }
#endif
}
```

```cpp
#include <hip/hip_runtime.h>
#include <hip/hip_cooperative_groups.h>
#include <cstdio>
#include <cstdint>
namespace cg = cooperative_groups;

#ifndef ONE_LAUNCH
#define ONE_LAUNCH 1
#endif

#define DI __device__ __forceinline__
typedef unsigned short u16;
typedef short bf16x8 __attribute__((ext_vector_type(8)));
typedef short s16x4 __attribute__((ext_vector_type(4)));
typedef float f32x2 __attribute__((ext_vector_type(2)));
typedef float f32x4 __attribute__((ext_vector_type(4)));
typedef float f32x16 __attribute__((ext_vector_type(16)));
typedef unsigned u32x2 __attribute__((ext_vector_type(2)));
typedef unsigned u32x4 __attribute__((ext_vector_type(4)));
typedef __bf16 bf16x2_t __attribute__((ext_vector_type(2)));

DI unsigned pack2(float a, float b) { f32x2 v = {a, b}; bf16x2_t r = __builtin_convertvector(v, bf16x2_t); return __builtin_bit_cast(unsigned, r); }
DI u16 f2bf(float a) { return (u16)(pack2(a, 0.f) & 0xffffu); }
DI float bflo(unsigned w) { return __uint_as_float(w << 16); }
DI float bfhi(unsigned w) { return __uint_as_float(w & 0xffff0000u); }
DI float bf2f(u16 v) { return __uint_as_float(((unsigned)v) << 16); }
#define MFMA16(a, b, c) __builtin_amdgcn_mfma_f32_16x16x32_bf16((a), (b), (c), 0, 0, 0)
#define MFMA32(a, b, c) __builtin_amdgcn_mfma_f32_32x32x16_bf16((a), (b), (c), 0, 0, 0)
DI float rcpf_(float x) { return __builtin_amdgcn_rcpf(x); }
DI float sigmoidf_(float z) { return rcpf_(1.f + __expf(-z)); }
DI float siluf_(float z) { return z * rcpf_(1.f + __expf(-z)); }
DI float ex2(float x) { return __builtin_amdgcn_exp2f(x); }
DI float xor32_max(float x) { auto t = __builtin_amdgcn_permlane32_swap(__float_as_uint(x), __float_as_uint(x), false, false); return fmaxf(__uint_as_float(t[0]), __uint_as_float(t[1])); }
DI float xor32_sum(float x) { auto t = __builtin_amdgcn_permlane32_swap(__float_as_uint(x), __float_as_uint(x), false, false); return __uint_as_float(t[0]) + __uint_as_float(t[1]); }
DI float xor16_sum(float x) { auto t = __builtin_amdgcn_permlane16_swap(__float_as_uint(x), __float_as_uint(x), false, false); return __uint_as_float(t[0]) + __uint_as_float(t[1]); }
template <int CTRL> DI float dpp_(float x) { return __builtin_bit_cast(float, __builtin_amdgcn_mov_dpp(__builtin_bit_cast(int, x), CTRL, 0xf, 0xf, true)); }
DI float quad_sum(float x) { x += dpp_<0xB1>(x); x += dpp_<0x4E>(x); return x; }
DI int tid_() { int t = threadIdx.x; asm volatile("" : "+v"(t)); return t; }
#define CFENCE asm volatile("" ::: "memory")
#define LBAR() do { asm volatile("s_waitcnt lgkmcnt(0)" ::: "memory"); __builtin_amdgcn_s_barrier(); asm volatile("" ::: "memory"); } while (0)

constexpr int NTHR = 512;
constexpr int TOK = 65536, SEQ = 2048, NBATCH = 32, DM = 1024;
constexpr int LDZ0 = 2816, LDZ1 = 4608, LDMIX = 1280;
constexpr float EPS = 1e-6f;
constexpr float SC_LOG2 = 0.125f * 1.4426950408889634f;
constexpr float LOG2E = 1.4426950408889634f;

constexpr size_t OFF_WT0 = 0;
constexpr size_t OFF_WT1 = OFF_WT0 + (size_t)2816 * 1024 * 2;
constexpr size_t OFF_WO0 = OFF_WT1 + (size_t)4608 * 1024 * 2;
constexpr size_t OFF_WO1 = OFF_WO0 + (size_t)1024 * 1280 * 2;
constexpr size_t OFF_WM = OFF_WO1 + (size_t)1024 * 1280 * 2;
constexpr size_t OFF_W1K = OFF_WM + (size_t)2 * 512 * 1024 * 2;
constexpr size_t OFF_W1V = OFF_W1K + (size_t)256 * 2048 * 2;
constexpr size_t OFF_COS = OFF_W1V + (size_t)256 * 2048 * 2;
constexpr size_t OFF_SIN = OFF_COS + (size_t)2048 * 32 * 4;
constexpr size_t OFF_RS0 = OFF_SIN + (size_t)2048 * 32 * 4;
constexpr size_t OFF_RS1 = OFF_RS0 + (size_t)TOK * 4;
constexpr size_t OFF_RSM = OFF_RS1 + (size_t)TOK * 4;
constexpr size_t OFF_BIAS = OFF_RSM + (size_t)8192 * 4;
constexpr size_t OFF_CTR = OFF_BIAS + 1024;
constexpr size_t OFF_BAR = OFF_CTR + 512;
constexpr size_t OFF_KC = OFF_CTR + 1024;
constexpr size_t OFF_VC = OFF_KC + (size_t)32 * 128 * 128 * 2;
constexpr size_t OFF_MKV = OFF_VC + (size_t)32 * 128 * 128 * 2;
constexpr size_t OFF_MEMB = OFF_MKV + (size_t)2 * 8192 * 512 * 2;
constexpr size_t OFF_XB = OFF_MEMB + (size_t)8192 * 1024 * 2;
constexpr size_t OFF_MIX = OFF_XB + (size_t)TOK * 1024 * 2;
constexpr size_t OFF_Z = OFF_MIX + (size_t)TOK * 1280 * 2;
constexpr size_t OFF_RSP = OFF_Z + (size_t)TOK * 4608 * 2;
constexpr size_t WS_END = OFF_RSP + (size_t)4 * TOK * 4;

struct Params { const float* in[33]; float* out; unsigned char* ws; int ph_lo, ph_hi; };

constexpr int LDS_BYTES = 155776;
constexpr int LDS_TR = 131072, LDS_RED = 147456;
constexpr int GP = 72;
constexpr int GP2 = 136;

struct ALPlain { const u16* A; int lda; static constexpr int dummy = 0; int kstride;
    DI const u16* rowptr(int row) const { return A + (size_t)row * lda; } };
struct ALCmp { const u16* Zc; int kstride;
    DI const u16* rowptr(int row) const { return Zc; } };

template <class Epi, bool CMP>
DI void gemm_unit(unsigned char* lds, const u16* Abase, int lda, int kstrideA, const u16* Bt, int ldb, int nk, int pm, int pn, Epi& epi) {
    const int tid = tid_(), wid = tid >> 6, lane = tid & 63, fr = lane & 15, fq = lane >> 4;
    const int wm = wid >> 2, wn = wid & 3;
    u16* As = (u16*)lds; u16* Bs = As + 2 * 256 * GP;
    const int lrow = tid >> 3, lc8 = (tid & 7) * 8;
    const u16* ap0; const u16* bp0 = Bt + (size_t)(pn * 256 + lrow) * ldb + lc8;
    const size_t bstep = (size_t)64 * ldb;
    const int atok0 = 16 * (lrow >> 1);
    if (CMP) ap0 = Abase + (size_t)(pm * SEQ) * lda + 64 * (lrow & 1) + lc8;
    else ap0 = Abase + (size_t)(pm * 256 + lrow) * lda + lc8;
    const size_t astep = (size_t)64 * lda;
    f32x4 acc[8][4];
#pragma unroll
    for (int a = 0; a < 8; ++a)
#pragma unroll
        for (int b = 0; b < 4; ++b) acc[a][b] = (f32x4){0.f, 0.f, 0.f, 0.f};
    u32x4 ra[4], rb[4];
#pragma unroll
    for (int i = 0; i < 4; ++i) {
        if (CMP) { int t = atok0 + 512 * i; t = t > SEQ - 1 ? SEQ - 1 : t; ra[i] = *(const u32x4*)(ap0 + (size_t)t * lda); }
        else ra[i] = *(const u32x4*)(ap0 + i * astep);
        rb[i] = *(const u32x4*)(bp0 + i * bstep);
    }
    __syncthreads();
#pragma unroll
    for (int i = 0; i < 4; ++i) { *(u32x4*)(As + (lrow + 64 * i) * GP + lc8) = ra[i]; *(u32x4*)(Bs + (lrow + 64 * i) * GP + lc8) = rb[i]; }
    __syncthreads();
    for (int kt = 0; kt < nk; ++kt) {
        const int buf = kt & 1;
        if (kt + 1 < nk) {
#pragma unroll
            for (int i = 0; i < 4; ++i) {
                if (CMP) { int t = atok0 + 512 * i + kt + 1; t = t > SEQ - 1 ? SEQ - 1 : t; ra[i] = *(const u32x4*)(ap0 + (size_t)t * lda); }
                else ra[i] = *(const u32x4*)(ap0 + i * astep + (size_t)(kt + 1) * kstrideA);
                rb[i] = *(const u32x4*)(bp0 + i * bstep + (size_t)(kt + 1) * 64);
            }
        }
        const u16* Ab = As + buf * 256 * GP + (128 * wm + fr) * GP + 8 * fq;
        const u16* Bb = Bs + buf * 256 * GP + (64 * wn + fr) * GP + 8 * fq;
#pragma unroll
        for (int ks = 0; ks < 2; ++ks) {
            bf16x8 bfr[4];
#pragma unroll
            for (int ni = 0; ni < 4; ++ni) bfr[ni] = *(const bf16x8*)(Bb + 16 * ni * GP + 32 * ks);
#pragma unroll
            for (int mi = 0; mi < 8; ++mi) {
                const bf16x8 afr = *(const bf16x8*)(Ab + 16 * mi * GP + 32 * ks);
#pragma unroll
                for (int ni = 0; ni < 4; ++ni) acc[mi][ni] = MFMA16(bfr[ni], afr, acc[mi][ni]);
            }
        }
        if (kt + 1 < nk) {
            u16* Aw = As + (buf ^ 1) * 256 * GP; u16* Bw = Bs + (buf ^ 1) * 256 * GP;
#pragma unroll
            for (int i = 0; i < 4; ++i) { *(u32x4*)(Aw + (lrow + 64 * i) * GP + lc8) = ra[i]; *(u32x4*)(Bw + (lrow + 64 * i) * GP + lc8) = rb[i]; }
        }
        LBAR();
    }
    epi(acc, pm * 256 + 128 * wm, pn * 256 + 64 * wn, lane, lds);
}


namespace pg8 {
#define PG8_LAS __attribute__((address_space(3)))
constexpr int BM = 256, BK = 64, HALF = 128, HTB = HALF * BK * 2, STAGE_BYTES = 8 * HTB;
DI int lds_byte(int r, int c) { const int st = (r >> 4) * 2 + (c >> 5), rr = r & 15, cc = c & 31, ob = rr * 64 + cc * 2; return st * 1024 + (ob ^ (((ob >> 9) & 1) << 5)); }
DI void stage_rc(int b, int& R, int& C) { const int st = b / 1024, sb = b % 1024, swz = sb ^ (((sb >> 9) & 1) << 5); R = (st >> 1) * 16 + swz / 64; C = (st & 1) * 32 + (swz % 64) / 2; }
struct Unit { int pm, pn; };
struct Gemm { const u16* A; const u16* Bt; int K; };

template <class Epi, class Sched, bool ALIGN_EPI>
DI void gemm_phase(PG8_LAS unsigned char* lds, const Gemm g, const Sched& S, Epi& E) {
    const int tid = tid_(), wid = __builtin_amdgcn_readfirstlane(tid >> 6), lane = tid & 63, wr = wid >> 2, wc = wid & 3, fr = lane & 15, fq = lane >> 4;
    const int K = g.K, nt = K / BK;
    unsigned voffA[2];
#pragma unroll
    for (int i = 0; i < 2; ++i) { int R, C; stage_rc(tid * 16 + i * 8192, R, C); voffA[i] = (unsigned)(R * K + C) * 2u; }
    const size_t kstep = (size_t)(BK * 2);
    const size_t hstep = (size_t)HALF * K * 2;
    const size_t tstep = 2 * hstep;
    const unsigned ldsw = (unsigned)wid * 1024u;
    const int aoff = lds_byte(wr * 64 + fr, fq * 8), boff = lds_byte(wc * 32 + fr, fq * 8);
#define PG8_SA(b, h) (((b) * 2 + (h)) * HTB)
#define PG8_SB(b, h) ((4 + (b) * 2 + (h)) * HTB)
#define PG8_STAGE(bufoff, gbase) do { _Pragma("unroll") for (int _i = 0; _i < 2; ++_i) \
        __builtin_amdgcn_global_load_lds((const unsigned*)((const char*)(gbase) + voffA[_i]), (PG8_LAS unsigned*)(lds + (bufoff) + ldsw + _i * 8192), 16, 0, 0); } while (0)
#define PG8_LDA(dst, b, h) do { _Pragma("unroll") for (int m = 0; m < 4; ++m) _Pragma("unroll") for (int k = 0; k < 2; ++k) dst[m][k] = *(const PG8_LAS bf16x8*)(lds + PG8_SA(b, h) + aoff + m * 2048 + k * 1024); } while (0)
#define PG8_LDB(dst, b, h) do { _Pragma("unroll") for (int n = 0; n < 2; ++n) _Pragma("unroll") for (int k = 0; k < 2; ++k) dst[n][k] = *(const PG8_LAS bf16x8*)(lds + PG8_SB(b, h) + boff + n * 2048 + k * 1024); } while (0)
#define PG8_MMA(ai, bj, At, Bt) do { __builtin_amdgcn_s_setprio(1); _Pragma("unroll") for (int m = 0; m < 4; ++m) _Pragma("unroll") for (int n = 0; n < 2; ++n) _Pragma("unroll") for (int k = 0; k < 2; ++k) \
        acc[ai][bj][m][n] = __builtin_amdgcn_mfma_f32_16x16x32_bf16(Bt[n][k], At[m][k], acc[ai][bj][m][n], 0, 0, 0); __builtin_amdgcn_s_setprio(0); } while (0)
#define PG8_WAIT_V(n) asm volatile("s_waitcnt vmcnt(" #n ")" ::: "memory")
#define PG8_WAIT_L(n) asm volatile("s_waitcnt lgkmcnt(" #n ")" ::: "memory")
#define PG8_BAR __builtin_amdgcn_s_barrier()
#define PG8_SCHED __builtin_amdgcn_sched_barrier(0)
    Unit cur, nxt; int ui = 0;
    if (!S.next(0, cur)) return;
    f32x4 acc[2][2][4][2];
#pragma unroll
    for (int a = 0; a < 2; ++a)
#pragma unroll
        for (int b = 0; b < 2; ++b)
#pragma unroll
            for (int m = 0; m < 4; ++m)
#pragma unroll
                for (int n = 0; n < 2; ++n) acc[a][b][m][n] = (f32x4){0.f, 0.f, 0.f, 0.f};
    bf16x8 At[4][2], B0[2][2], B1[2][2];
    const char* cA = (const char*)g.A + (size_t)cur.pm * tstep; const char* cB = (const char*)g.Bt + (size_t)cur.pn * tstep;
    E.pre(cur, wr, fr);
    PG8_STAGE(PG8_SB(0, 0), cB); PG8_STAGE(PG8_SB(0, 1), cB + hstep); PG8_STAGE(PG8_SA(0, 0), cA); PG8_STAGE(PG8_SA(0, 1), cA + hstep);
    if (wr == 1) PG8_BAR;
    PG8_WAIT_V(2); PG8_BAR;
    PG8_STAGE(PG8_SB(1, 0), cB + kstep); PG8_STAGE(PG8_SA(1, 0), cA + kstep); PG8_STAGE(PG8_SB(1, 1), cB + hstep + kstep);
    PG8_WAIT_V(6); PG8_BAR;
    for (;;) {
        const bool has_next = S.next(ui + 1, nxt);
        const char* nA = has_next ? (const char*)g.A + (size_t)nxt.pm * tstep : cA; const char* nB = has_next ? (const char*)g.Bt + (size_t)nxt.pn * tstep : cB;
        for (int t = 0; t < nt; t += 2) {
            const bool last = (t == nt - 2);
            const char* a1 = cA + (size_t)(t + 1) * kstep;
            const char* a2 = last ? nA : cA + (size_t)(t + 2) * kstep; const char* b2 = last ? nB : cB + (size_t)(t + 2) * kstep;
            const char* a3 = a2 + kstep; const char* b3 = b2 + kstep;
            PG8_LDB(B0, 0, 0); PG8_LDB(B1, 0, 1); PG8_SCHED; PG8_LDA(At, 0, 0); PG8_STAGE(PG8_SA(1, 1), a1 + hstep);
            PG8_WAIT_V(8); PG8_WAIT_L(0); PG8_BAR; PG8_MMA(0, 0, At, B0); PG8_MMA(0, 1, At, B1); PG8_BAR; PG8_SCHED;
            PG8_LDA(At, 0, 1); PG8_STAGE(PG8_SB(0, 0), b2); PG8_STAGE(PG8_SB(0, 1), b2 + hstep); PG8_STAGE(PG8_SA(0, 0), a2);
            PG8_WAIT_V(8); PG8_WAIT_L(0); PG8_BAR; PG8_MMA(1, 0, At, B0); PG8_MMA(1, 1, At, B1); PG8_BAR; PG8_SCHED;
            PG8_LDB(B0, 1, 0); PG8_LDB(B1, 1, 1); PG8_SCHED; PG8_LDA(At, 1, 0); PG8_STAGE(PG8_SA(0, 1), a2 + hstep);
            PG8_WAIT_V(8); PG8_WAIT_L(0); PG8_BAR; PG8_MMA(0, 0, At, B0); PG8_MMA(0, 1, At, B1); PG8_BAR; PG8_SCHED;
            PG8_LDA(At, 1, 1); PG8_STAGE(PG8_SB(1, 0), b3); PG8_STAGE(PG8_SB(1, 1), b3 + hstep); PG8_STAGE(PG8_SA(1, 0), a3);
            PG8_WAIT_V(8); PG8_WAIT_L(0); PG8_BAR; PG8_MMA(1, 0, At, B0); PG8_MMA(1, 1, At, B1); PG8_BAR; PG8_SCHED;
        }
        if constexpr (ALIGN_EPI) { if (wr == 0) PG8_BAR; }
        E(acc, cur, wr, wc, fr, fq);
        if (!has_next) break;
#pragma unroll
        for (int a = 0; a < 2; ++a)
#pragma unroll
            for (int b = 0; b < 2; ++b)
#pragma unroll
                for (int m = 0; m < 4; ++m)
#pragma unroll
                    for (int n = 0; n < 2; ++n) acc[a][b][m][n] = (f32x4){0.f, 0.f, 0.f, 0.f};
        cur = nxt; cA = nA; cB = nB; ++ui;
        E.pre(cur, wr, fr);
        if constexpr (ALIGN_EPI) { if (wr == 1) PG8_BAR; }
    }
    PG8_WAIT_V(0);
    if constexpr (!ALIGN_EPI) { if (wr == 0) PG8_BAR; }
    PG8_BAR;
#undef PG8_SA
#undef PG8_SB
#undef PG8_STAGE
#undef PG8_LDA
#undef PG8_LDB
#undef PG8_MMA
#undef PG8_WAIT_V
#undef PG8_WAIT_L
#undef PG8_BAR
#undef PG8_SCHED
}
struct SchedIn { int NT, per, slot, xcd;
    DI bool next(int i, Unit& u) const { const int U = slot + i * per; if (U >= 32 * NT) return false; const int g = U / (8 * NT), r = U - g * 8 * NT; u.pm = xcd * 32 + 8 * g + (r & 7); u.pn = r >> 3; return true; } };
struct SchedOut { int pm;
    DI bool next(int i, Unit& u) const { if (i >= 4) return false; u.pm = pm; u.pn = i; return true; } };
struct SchedOutX { int per, slot, xcd;
    DI bool next(int i, Unit& u) const { const int U = slot + i * per; if (U >= 128) return false; u.pm = xcd * 32 + 8 * (U >> 5) + (U & 7); u.pn = (U & 31) >> 3; return true; } };
struct SchedOne { int pm, pn; bool on;
    DI bool next(int i, Unit& u) const { if (i > 0 || !on) return false; u.pm = pm; u.pn = pn; return true; } };
}


DI void tr_put8(unsigned char* T, int fr, int chunk, int half8, u32x2 w) { *(u32x2*)(T + fr * 128 + ((chunk ^ (fr & 7)) << 4) + half8 * 8) = w; }
DI void tr_put16(unsigned char* T, int fr, int chunk, f32x4 w) { *(f32x4*)(T + fr * 128 + ((chunk ^ (fr & 7)) << 4)) = w; }
DI u32x4 tr_get(const unsigned char* T, int r, int chunk) { return *(const u32x4*)(T + r * 128 + ((chunk ^ (r & 7)) << 4)); }

enum { OP_PLAIN = 0, OP_NORMROPE = 1, OP_NORM = 2, OP_SILU = 3, OP_SIGMOID = 4, OP_LOGF = 5 };

struct EpiZ {
    u16* Z; int ldz; const float* rs; int layer; const Params* p; const float* cs; const float* sn; unsigned char* tr; bool rs4;
    DI void pre(const pg8::Unit&, int, int) {}
    DI void operator()(f32x4 (&acc)[2][2][4][2], const pg8::Unit& u, int wr, int wc, int fr, int fq) {
        asm volatile("" : "+v"(fr), "+v"(fq));
        const int row0 = 256 * u.pm + 64 * wr, col0 = 256 * u.pn + 64 * wc, grp = col0 >> 6;
        int op = OP_PLAIN; const float* gain = nullptr;
        if (layer == 0) {
            if (grp < 8) { op = OP_NORMROPE; gain = p->in[9]; }
            else if (grp < 10) { op = OP_NORMROPE; gain = p->in[10]; }
            else if (grp < 12) op = OP_PLAIN;
            else if (grp < 20) op = OP_SILU;
            else if (grp < 28) op = OP_PLAIN;
            else if (grp < 36) op = OP_SILU;
            else if (grp < 40) { op = OP_NORM; gain = p->in[5]; }
            else op = OP_SILU;
        } else if (layer == 1) {
            if (grp < 8) op = OP_SILU;
            else if (grp < 16) op = OP_LOGF;
            else if (grp < 24) op = OP_PLAIN;
            else if (grp < 32) op = OP_SILU;
            else if (grp < 40) { op = OP_NORMROPE; gain = p->in[23]; }
            else if (grp < 44) op = OP_PLAIN;
            else if (grp < 46) { op = OP_NORMROPE; gain = p->in[25]; }
            else if (grp < 48) op = OP_PLAIN;
            else if (grp < 50) { op = OP_NORMROPE; gain = p->in[26]; }
            else if (grp < 52) op = OP_PLAIN;
            else if (grp < 60) op = OP_SILU;
            else if (grp < 64) { op = OP_NORM; gain = p->in[5] + 64; }
            else if (grp < 68) op = OP_SILU;
            else if (grp < 69) op = OP_SIGMOID;
            else op = OP_PLAIN;
        } else {
            if (grp < 4) { op = OP_NORM; gain = p->in[6] + 64 * (layer - 2); }
            else op = OP_PLAIN;
        }
        f32x4 gn[4];
        if (op == OP_NORMROPE || op == OP_NORM) {
#pragma unroll
            for (int ni = 0; ni < 4; ++ni) gn[ni] = *(const f32x4*)(gain + 16 * ni + 4 * fq);
        } else if (op == OP_LOGF) {
            const float* lbp = p->in[21]; const int ch0 = (grp - 8) * 64;
#pragma unroll
            for (int ni = 0; ni < 4; ++ni) {
                const f32x4 p0 = *(const f32x4*)(lbp + ch0 + 16 * ni + 4 * fq), p1 = *(const f32x4*)(lbp + 512 + ch0 + 16 * ni + 4 * fq);
#pragma unroll
                for (int r = 0; r < 4; ++r) gn[ni][r] = 1.f / (1.f + expf(p0[r] - p1[r]));
            }
        }
        float rsv[8];
#pragma unroll
        for (int mi = 0; mi < 8; ++mi) {
            const float* rp = rs + row0 + 128 * (mi >> 2) + 16 * (mi & 3) + fr;
            rsv[mi] = rs4 ? rsqrtf(((rp[0] + rp[TOK]) + (rp[2 * TOK] + rp[3 * TOK])) * (1.f / 1024.f) + EPS) : rp[0];
        }
        f32x4 invf[2];
        if (op == OP_NORMROPE) {
#pragma unroll
            for (int ni = 0; ni < 2; ++ni)
#pragma unroll
                for (int r = 0; r < 4; ++r) invf[ni][r] = exp2f(-(float)(16 * ni + 4 * fq + r) * (13.287712379549449f / 32.f)) * 0.15915494309189535f;
        }
#pragma unroll
        for (int mi = 0; mi < 8; ++mi) {
            const int row = row0 + 128 * (mi >> 2) + 16 * (mi & 3) + fr;
            const float s = rsv[mi];
            f32x4 v[4];
#pragma unroll
            for (int ni = 0; ni < 4; ++ni) v[ni] = acc[mi >> 2][ni >> 1][mi & 3][ni & 1] * s;
            if (op == OP_NORMROPE || op == OP_NORM) {
                float ss = 0.f;
#pragma unroll
                for (int ni = 0; ni < 4; ++ni) ss += v[ni][0] * v[ni][0] + v[ni][1] * v[ni][1] + v[ni][2] * v[ni][2] + v[ni][3] * v[ni][3];
                ss = xor32_sum(xor16_sum(ss));
                const float inv = rsqrtf(ss * (1.f / 64.f) + EPS);
#pragma unroll
                for (int ni = 0; ni < 4; ++ni) v[ni] = v[ni] * inv * gn[ni];
                if (op == OP_NORMROPE) {
#pragma unroll
                    for (int ni = 0; ni < 2; ++ni) {
                        const float tf = (float)(row & (SEQ - 1));
                        f32x4 c, sv;
#pragma unroll
                        for (int r = 0; r < 4; ++r) { const float fx = __builtin_amdgcn_fractf(tf * invf[ni][r]); c[r] = __builtin_amdgcn_cosf(fx); sv[r] = __builtin_amdgcn_sinf(fx); }
                        const f32x4 x1 = v[ni], x2 = v[ni + 2];
                        v[ni] = x1 * c - x2 * sv; v[ni + 2] = x2 * c + x1 * sv;
                    }
                }
            } else if (op == OP_SILU) {
#pragma unroll
                for (int ni = 0; ni < 4; ++ni)
#pragma unroll
                    for (int r = 0; r < 4; ++r) v[ni][r] = siluf_(v[ni][r]);
            } else if (op == OP_SIGMOID) {
#pragma unroll
                for (int ni = 0; ni < 4; ++ni)
#pragma unroll
                    for (int r = 0; r < 4; ++r) v[ni][r] = sigmoidf_(v[ni][r]);
            } else if (op == OP_LOGF) {
#pragma unroll
                for (int ni = 0; ni < 4; ++ni)
#pragma unroll
                    for (int r = 0; r < 4; ++r) { const float lb = gn[ni][r]; v[ni][r] = __logf(lb + (1.f - lb) * sigmoidf_(v[ni][r])); }
            }
#pragma unroll
            for (int ni = 0; ni < 4; ++ni) { u32x2 w; w.x = pack2(v[ni][0], v[ni][1]); w.y = pack2(v[ni][2], v[ni][3]); tr_put8(tr, fr, 2 * ni + (fq >> 1), fq & 1, w); }
            {
                const int lane = fr + 16 * fq, c8 = lane & 7;
                const int rb = row0 + 128 * (mi >> 2) + 16 * (mi & 3);
#pragma unroll
                for (int k = 0; k < 2; ++k) { const int r = (lane >> 3) + 8 * k; __builtin_nontemporal_store(tr_get(tr, r, c8), (u32x4*)(Z + (size_t)(rb + r) * ldz + col0 + 8 * c8)); }
            }
            CFENCE;
        }
    }
};

struct EpiOut0 {
    const float* x; float* out; u16* xb; float* red; unsigned char* tr; float* rsp;
    int par, ppm, ppn;
    DI void pre(const pg8::Unit&, int, int) {}
    DI void flush(int wr, int wc, int fr, int fq) {
        if (ppm >= 0 && wc == 0 && fq == 0) {
            const float* rd = red + (par ^ 1) * 1024;
#pragma unroll
            for (int mi = 0; mi < 8; ++mi) {
                const int r = 64 * wr + 128 * (mi >> 2) + 16 * (mi & 3) + fr;
                rsp[(size_t)ppn * TOK + 256 * ppm + r] = (rd[r] + rd[256 + r]) + (rd[512 + r] + rd[768 + r]);
            }
        }
    }
    DI void operator()(f32x4 (&acc)[2][2][4][2], const pg8::Unit& u, int wr, int wc, int fr, int fq) {
        asm volatile("" : "+v"(fr), "+v"(fq));
        const int row0 = 256 * u.pm + 64 * wr, col0 = 256 * u.pn + 64 * wc;
        const int lane = fr + 16 * fq, c8 = lane & 7, lr = lane >> 3;
        f32x4 xr[2][2];
#pragma unroll
        for (int k = 0; k < 2; ++k) xr[0][k] = __builtin_nontemporal_load((const f32x4*)(x + (size_t)(row0 + lr + 8 * k) * DM + col0 + 4 * c8));
        flush(wr, wc, fr, fq);
        float* rw = red + par * 1024 + wc * 256 + 64 * wr;
        float ss = 0.f; u32x2 wq[2][2];
#pragma unroll
        for (int st = 0; st < 16; ++st) {
            const int mi = st >> 1, hh = st & 1;
            const int rl = 128 * (mi >> 2) + 16 * (mi & 3) + fr;
            if (st < 15) {
                const int mn = (st + 1) >> 1, hn = (st + 1) & 1;
                const int rbn = row0 + 128 * (mn >> 2) + 16 * (mn & 3);
#pragma unroll
                for (int k = 0; k < 2; ++k) xr[(st + 1) & 1][k] = __builtin_nontemporal_load((const f32x4*)(x + (size_t)(rbn + lr + 8 * k) * DM + col0 + 32 * hn + 4 * c8));
            }
#pragma unroll
            for (int k = 0; k < 2; ++k) tr_put16(tr, lr + 8 * k, c8, xr[st & 1][k]);
#pragma unroll
            for (int n = 0; n < 2; ++n) {
                const f32x4 xv = *(const f32x4*)(tr + fr * 128 + (((4 * n + fq) ^ (fr & 7)) << 4));
                const f32x4 v = acc[mi >> 2][hh][mi & 3][n] + xv;
                wq[hh][n].x = pack2(v[0], v[1]); wq[hh][n].y = pack2(v[2], v[3]);
                ss += v[0] * v[0] + v[1] * v[1] + v[2] * v[2] + v[3] * v[3];
            }
            if (hh) {
                ss = xor32_sum(xor16_sum(ss));
                if (fq == 0) rw[rl] = ss;
                ss = 0.f;
#pragma unroll
                for (int h2 = 0; h2 < 2; ++h2)
#pragma unroll
                    for (int n = 0; n < 2; ++n) tr_put8(tr, fr, 2 * (2 * h2 + n) + (fq >> 1), fq & 1, wq[h2][n]);
                const int rb = row0 + 128 * (mi >> 2) + 16 * (mi & 3);
#pragma unroll
                for (int k = 0; k < 2; ++k) { const int r = lr + 8 * k; *(u32x4*)(xb + (size_t)(rb + r) * DM + col0 + 8 * c8) = tr_get(tr, r, c8); }
            }
            CFENCE;
        }
        ppm = u.pm; ppn = u.pn; par ^= 1;
    }
};
struct EpiOut1 {
    float* out; const u16* xb; unsigned char* tr;
    DI void pre(const pg8::Unit&, int, int) {}
    DI void operator()(f32x4 (&acc)[2][2][4][2], const pg8::Unit& u, int wr, int wc, int fr, int fq) const {
        asm volatile("" : "+v"(fr), "+v"(fq));
        const int row0 = 256 * u.pm + 64 * wr, col0 = 256 * u.pn + 64 * wc;
        const int lane = fr + 16 * fq, c8 = lane & 7, lr = lane >> 3;
        u32x4 hb[2][2];
#pragma unroll
        for (int k = 0; k < 2; ++k) hb[0][k] = *(const u32x4*)(xb + (size_t)(row0 + lr + 8 * k) * DM + col0 + 8 * c8);
#pragma unroll
        for (int mi = 0; mi < 8; ++mi) {
            const int rb = row0 + 128 * (mi >> 2) + 16 * (mi & 3);
            if (mi < 7) {
                const int rbn = row0 + 128 * ((mi + 1) >> 2) + 16 * ((mi + 1) & 3);
#pragma unroll
                for (int k = 0; k < 2; ++k) hb[(mi + 1) & 1][k] = *(const u32x4*)(xb + (size_t)(rbn + lr + 8 * k) * DM + col0 + 8 * c8);
            }
#pragma unroll
            for (int k = 0; k < 2; ++k) { const int r = lr + 8 * k; *(u32x4*)(tr + r * 128 + ((c8 ^ (r & 7)) << 4)) = hb[mi & 1][k]; }
            u32x2 hw[4];
#pragma unroll
            for (int ni = 0; ni < 4; ++ni) hw[ni] = *(const u32x2*)(tr + fr * 128 + (((2 * ni + (fq >> 1)) ^ (fr & 7)) << 4) + 8 * (fq & 1));
#pragma unroll
            for (int hh = 0; hh < 2; ++hh) {
#pragma unroll
                for (int n = 0; n < 2; ++n) {
                    const u32x2 w = hw[2 * hh + n];
                    const f32x4 a = acc[mi >> 2][hh][mi & 3][n];
                    tr_put16(tr, fr, 4 * n + fq, (f32x4){bflo(w.x) + a[0], bfhi(w.x) + a[1], bflo(w.y) + a[2], bfhi(w.y) + a[3]});
                }
#pragma unroll
                for (int k = 0; k < 2; ++k) { const int r = lr + 8 * k; __builtin_nontemporal_store(tr_get(tr, r, c8), (u32x4*)(out + (size_t)(rb + r) * DM + col0 + 32 * hh + 4 * c8)); }
            }
            CFENCE;
        }
    }
};

struct EpiCmp {
    const float* bias; const float* w2; const float* gain; u16* dst; bool isk; const float* cs; const float* sn;
    DI void operator()(f32x4 (&acc)[8][4], int row0, int col0, int lane, unsigned char* lds) const {
        const int fr = lane & 15, fq = lane >> 4, tid = tid_();
        float* Hs = (float*)lds;
        if (col0 < 128) {
            const int lrow0 = row0 & 255;
#pragma unroll
            for (int mi = 0; mi < 8; ++mi)
#pragma unroll
                for (int ni = 0; ni < 4; ++ni)
#pragma unroll
                    for (int r = 0; r < 4; ++r) { const int c = col0 + 16 * ni + 4 * fq + r; Hs[(lrow0 + 16 * mi + fr) * 129 + c] = siluf_(acc[mi][ni][r] + bias[c]); }
        }
        __syncthreads();
        const int lrow = tid >> 1, half = tid & 1;
        const int row = (row0 & ~255) + lrow;
        float o[32];
#pragma unroll
        for (int c = 0; c < 32; ++c) o[c] = 0.f;
        for (int j = 0; j < 128; ++j) {
            const float hv = Hs[lrow * 129 + j];
            const float* wr = w2 + j * 64 + 32 * half;
#pragma unroll
            for (int c4 = 0; c4 < 8; ++c4) { const f32x4 w = *(const f32x4*)(wr + 4 * c4); o[4 * c4] += hv * w[0]; o[4 * c4 + 1] += hv * w[1]; o[4 * c4 + 2] += hv * w[2]; o[4 * c4 + 3] += hv * w[3]; }
        }
        if (isk) {
            float ss = 0.f;
#pragma unroll
            for (int c = 0; c < 32; ++c) ss += o[c] * o[c];
            ss += __shfl_xor(ss, 1);
            const float inv = rsqrtf(ss * (1.f / 64.f) + EPS);
            const int n = (row >> 1) & 127; int t = 16 * n + 31; t = t > SEQ - 1 ? SEQ - 1 : t;
#pragma unroll
            for (int c = 0; c < 32; ++c) {
                const float mine = o[c] * inv * gain[32 * half + c];
                const float other = __shfl_xor(mine, 1);
                const float cv = cs[t * 32 + c], sv = sn[t * 32 + c];
                o[c] = half == 0 ? (mine * cv - other * sv) : (mine * cv + other * sv);
            }
        }
        u16* dp = dst + (size_t)row * 64 + 32 * half;
#pragma unroll
        for (int c8 = 0; c8 < 4; ++c8) { u32x4 w; w.x = pack2(o[8 * c8], o[8 * c8 + 1]); w.y = pack2(o[8 * c8 + 2], o[8 * c8 + 3]); w.z = pack2(o[8 * c8 + 4], o[8 * c8 + 5]); w.w = pack2(o[8 * c8 + 6], o[8 * c8 + 7]); *(u32x4*)(dp + 8 * c8) = w; }
        __syncthreads();
    }
};

DI int srccol(int mode, int n) {
    if (mode == 0) return n;
    if (mode == 1) { if (n < 3328) return n; if (n < 4352) return n + 24; if (n < 4376) return n - 1024; return -1; }
    return n < 128 ? n : -1;
}
DI int physrow(int n) { const int w = n & 255; return (n & ~255) + 128 * ((w >> 5) & 1) + 32 * (w >> 6) + (w & 31); }
DI void tconv(unsigned char* lds, const float* src, int ldsrc, int K, int N, u16* dst, const float* gain, int mode, int first, int stride) {
    float* tl = (float*)lds;
    const int tid = tid_(), nkt = K / 64, ntile = nkt * (N / 64);
    for (int tile = first; tile < ntile; tile += stride) {
        const int k0 = (tile % nkt) * 64, n0 = (tile / nkt) * 64;
#pragma unroll
        for (int i = 0; i < 8; ++i) {
            const int k = (tid >> 6) + 8 * i, n = tid & 63; const int sc = srccol(mode, n0 + n);
            float v = 0.f; if (sc >= 0) { v = src[(size_t)(k0 + k) * ldsrc + sc]; if (gain) v *= gain[k0 + k]; }
            tl[k * 65 + n] = v;
        }
        __syncthreads();
#pragma unroll
        for (int i = 0; i < 8; ++i) { const int n = (tid >> 6) + 8 * i, k = tid & 63; const int pr = mode == 2 ? n0 + n : physrow(n0 + n); dst[(size_t)pr * K + k0 + k] = f2bf(tl[k * 65 + n]); }
        __syncthreads();
    }
}
DI void phase_prep(const Params& p, unsigned char* lds) {
    unsigned char* ws = p.ws;
    const int tid = tid_(), wid = tid >> 6, lane = tid & 63;
    if (blockIdx.x == 0 && tid < 256) ((unsigned*)(ws + OFF_CTR))[tid] = 0u;
    for (int rb = blockIdx.x; rb < (TOK + 8192) / 16; rb += gridDim.x) {
        f32x4 v[2][4]; const float* src[2]; u16* dst[2]; float* rsd[2];
#pragma unroll
        for (int h = 0; h < 2; ++h) {
            const int r = rb * 16 + 2 * wid + h;
            if (r < TOK) { src[h] = p.in[0] + (size_t)r * DM; dst[h] = (u16*)(ws + OFF_XB) + (size_t)r * DM; rsd[h] = (float*)(ws + OFF_RS0) + r; }
            else { const int rr = r - TOK; src[h] = p.in[1] + (size_t)rr * DM; dst[h] = (u16*)(ws + OFF_MEMB) + (size_t)rr * DM; rsd[h] = (float*)(ws + OFF_RSM) + rr; }
#pragma unroll
            for (int i = 0; i < 4; ++i) v[h][i] = __builtin_nontemporal_load((const f32x4*)(src[h] + 4 * (lane + 64 * i)));
        }
#pragma unroll
        for (int h = 0; h < 2; ++h) {
            float ss = 0.f;
#pragma unroll
            for (int i = 0; i < 4; ++i) ss += v[h][i][0] * v[h][i][0] + v[h][i][1] * v[h][i][1] + v[h][i][2] * v[h][i][2] + v[h][i][3] * v[h][i][3];
#pragma unroll
            for (int o = 1; o < 64; o <<= 1) ss += __shfl_xor(ss, o);
            if (lane == 0) *rsd[h] = rsqrtf(ss * (1.f / 1024.f) + EPS);
#pragma unroll
            for (int i = 0; i < 4; ++i) { u32x2 w; w.x = pack2(v[h][i][0], v[h][i][1]); w.y = pack2(v[h][i][2], v[h][i][3]); *(u32x2*)(dst[h] + 4 * (lane + 64 * i)) = w; }
        }
    }
    const int b0 = blockIdx.x, gs = gridDim.x;
    tconv(lds, p.in[7], 2816, 1024, 2816, (u16*)(ws + OFF_WT0), p.in[2], 0, b0, gs);
    tconv(lds, p.in[8], 1024, 1280, 1024, (u16*)(ws + OFF_WO0), nullptr, 0, b0, gs);
    tconv(lds, p.in[4], 512, 1024, 512, (u16*)(ws + OFF_WM), p.in[3], 0, b0, gs);
    tconv(lds, p.in[4] + (size_t)1024 * 512, 512, 1024, 512, (u16*)(ws + OFF_WM) + (size_t)512 * 1024, p.in[3] + 1024, 0, b0, gs);
    for (int idx = blockIdx.x * NTHR + tid; idx < 2048 * 32; idx += gridDim.x * NTHR) {
        const int t = idx >> 5, i = idx & 31;
        const float inv = exp2f(-(float)i * (13.287712379549449f / 32.f));
        const double rev = (double)t * (double)inv * 0.15915494309189535;
        const float fr = (float)(rev - floor(rev));
        ((float*)(ws + OFF_COS))[idx] = __builtin_amdgcn_cosf(fr);
        ((float*)(ws + OFF_SIN))[idx] = __builtin_amdgcn_sinf(fr);
    }
}
DI void prep_layer1(const Params& p, unsigned char* lds, int first, int stride) {
    unsigned char* ws = p.ws;
    const int tid = tid_(), wid = tid >> 6, lane = tid & 63;
    __syncthreads();
    tconv(lds, p.in[19], 4376, 1024, 4608, (u16*)(ws + OFF_WT1), p.in[2] + 1024, 1, first, stride);
    tconv(lds, p.in[20], 1024, 1280, 1024, (u16*)(ws + OFF_WO1), nullptr, 0, first, stride);
    tconv(lds, p.in[29], 128, 2048, 256, (u16*)(ws + OFF_W1K), nullptr, 2, first, stride);
    tconv(lds, p.in[31], 128, 2048, 256, (u16*)(ws + OFF_W1V), nullptr, 2, first, stride);
    for (int task = first; task < 32; task += stride) {
        const int kv = task >> 4, j = (task & 15) * 8 + wid;
        const float* pe = kv ? p.in[28] : p.in[27]; const float* w1 = kv ? p.in[31] : p.in[29];
        float s = 0.f;
        for (int i = lane; i < 2048; i += 64) s += pe[i] * w1[(size_t)i * 128 + j];
#pragma unroll
        for (int o = 1; o < 64; o <<= 1) s += __shfl_xor(s, o);
        if (lane == 0) ((float*)(ws + OFF_BIAS))[kv * 128 + j] = s;
    }
}

struct TileSrc { const u16* k; const u16* v; int kstride, vstride; };
DI void tile_load(const TileSrc& s, u32x4& rk, u32x4& rv, int tid) {
    rk = *(const u32x4*)(s.k + (size_t)(tid >> 3) * s.kstride + (tid & 7) * 8);
    rv = *(const u32x4*)(s.v + (size_t)(tid >> 3) * s.vstride + (tid & 7) * 8);
}
DI void tile_store(u16* Kt, u16* Vt, const u32x4& rk, const u32x4& rv, int tid) {
    *(u32x4*)(Kt + (tid >> 3) * GP + (tid & 7) * 8) = rk;
    *(u32x4*)(Vt + (tid >> 3) * GP + (tid & 7) * 8) = rv;
}
typedef __attribute__((address_space(3))) s16x4 lds_s16x4;
DI s16x4 tr_read(const u16* p) { return __builtin_amdgcn_ds_read_tr16_b64_v4i16((lds_s16x4*)p); }
struct AttnAcc { f32x16 o[2]; float m, l; };
DI void attn_reset(AttnAcc& a) {
#pragma unroll
    for (int i = 0; i < 16; ++i) { a.o[0][i] = 0.f; a.o[1][i] = 0.f; }
    a.m = -1e30f; a.l = 0.f;
}
template <int MODE, class MaskF>
DI void attn_compute(const u16* Kt, const u16* Vt, const bf16x8 (&q)[4], AttnAcc& st, int lane, bool rowon, MaskF valid) {
    const int r32 = lane & 31, h = lane >> 5;
    f32x16 X[2];
#pragma unroll
    for (int kt2 = 0; kt2 < 2; ++kt2) {
#pragma unroll
        for (int i = 0; i < 16; ++i) X[kt2][i] = 0.f;
#pragma unroll
        for (int s = 0; s < 4; ++s) { const bf16x8 kf = *(const bf16x8*)(Kt + (32 * kt2 + r32) * GP + 16 * s + 8 * h); X[kt2] = MFMA32(kf, q[s], X[kt2]); }
    }
#pragma unroll
    for (int i = 0; i < 8; ++i) { __builtin_amdgcn_sched_group_barrier(0x100, 1, 0); __builtin_amdgcn_sched_group_barrier(0x008, 1, 0); }
    float mx = -1e30f;
    if (MODE == 0) {
#pragma unroll
        for (int kt2 = 0; kt2 < 2; ++kt2)
#pragma unroll
            for (int reg = 0; reg < 16; ++reg) {
                const int kl = 32 * kt2 + (reg & 3) + 8 * (reg >> 2) + 4 * h;
                float t = X[kt2][reg]; t = valid(kl) ? t : -1e30f; X[kt2][reg] = t; mx = fmaxf(mx, t);
            }
    } else {
#pragma unroll
        for (int kt2 = 0; kt2 < 2; ++kt2)
#pragma unroll
            for (int reg = 0; reg < 16; ++reg) mx = fmaxf(mx, X[kt2][reg]);
        if (MODE == 2) mx = rowon ? mx : -1e30f;
    }
    mx = xor32_max(mx);
    const float mn = fmaxf(st.m, mx > -1e29f ? mx * SC_LOG2 : -1e30f);
    const float alpha = ex2(st.m - mn);
    float rsum = 0.f;
#pragma unroll
    for (int kt2 = 0; kt2 < 2; ++kt2)
#pragma unroll
        for (int reg = 0; reg < 16; ++reg) {
            const float t = X[kt2][reg]; float pv = ex2(fmaf(t, SC_LOG2, -mn));
            if (MODE == 0) pv = t > -1e29f ? pv : 0.f;
            if (MODE == 2) pv = rowon ? pv : 0.f;
            X[kt2][reg] = pv; rsum += pv;
        }
    rsum = xor32_sum(rsum);
    st.l = st.l * alpha + rsum; st.m = mn;
#pragma unroll
    for (int i = 0; i < 16; ++i) { st.o[0][i] *= alpha; st.o[1][i] *= alpha; }
    bf16x8 pf[2][2];
#pragma unroll
    for (int kt2 = 0; kt2 < 2; ++kt2)
#pragma unroll
        for (int s = 0; s < 2; ++s) {
            u32x4 w; w.x = pack2(X[kt2][8 * s], X[kt2][8 * s + 1]); w.y = pack2(X[kt2][8 * s + 2], X[kt2][8 * s + 3]);
            w.z = pack2(X[kt2][8 * s + 4], X[kt2][8 * s + 5]); w.w = pack2(X[kt2][8 * s + 6], X[kt2][8 * s + 7]);
            pf[kt2][s] = __builtin_bit_cast(bf16x8, w);
        }
#pragma unroll
    for (int nt = 0; nt < 2; ++nt)
#pragma unroll
        for (int kt2 = 0; kt2 < 2; ++kt2)
#pragma unroll
            for (int s = 0; s < 2; ++s) {
                const u16* vp = Vt + (32 * kt2 + 16 * s + 4 * h + ((lane & 15) >> 2)) * GP + 32 * nt + 16 * ((lane >> 4) & 1) + 4 * (lane & 3);
                const s16x4 lo = tr_read(vp), hi = tr_read(vp + 8 * GP);
                const bf16x8 vf = __builtin_shufflevector(lo, hi, 0, 1, 2, 3, 4, 5, 6, 7);
                st.o[nt] = MFMA32(vf, pf[kt2][s], st.o[nt]);
            }
}
constexpr int LDS_WT = 98304;
DI unsigned char* wtile(unsigned char* lds, int wid) { return lds + LDS_WT + 4096 * wid; }
template <class RowF> DI void rows_to_tile(unsigned char* T, int lane, RowF rowptr) {
#pragma unroll
    for (int k = 0; k < 4; ++k) { const int rr = (lane >> 3) + 8 * k, c = lane & 7; const u32x4 v = *(const u32x4*)(rowptr(rr) + 8 * c); *(u32x4*)(T + rr * 128 + ((c ^ (rr & 7)) << 4)) = v; }
}
template <class RowF> DI void tile_to_rows(const unsigned char* T, int lane, RowF rowptr) {
#pragma unroll
    for (int k = 0; k < 4; ++k) { const int rr = (lane >> 3) + 8 * k, c = lane & 7; *(u32x4*)(rowptr(rr) + 8 * c) = *(const u32x4*)(T + rr * 128 + ((c ^ (rr & 7)) << 4)); }
}
template <class RowF, class GateF> DI void load_q(unsigned char* T, bf16x8 (&q)[4], int lane, RowF qrow, GateF gaterow) {
    u32x4 qv[4], gv[4];
#pragma unroll
    for (int k = 0; k < 4; ++k) { const int rr = (lane >> 3) + 8 * k, c = lane & 7; qv[k] = *(const u32x4*)(qrow(rr) + 8 * c); }
#pragma unroll
    for (int k = 0; k < 4; ++k) { const int rr = (lane >> 3) + 8 * k, c = lane & 7; gv[k] = *(const u32x4*)(gaterow(rr) + 8 * c); }
#pragma unroll
    for (int k = 0; k < 4; ++k) { const int rr = (lane >> 3) + 8 * k, c = lane & 7; *(u32x4*)(T + rr * 128 + ((c ^ (rr & 7)) << 4)) = qv[k]; }
    const int r32 = lane & 31, h = lane >> 5;
#pragma unroll
    for (int s = 0; s < 4; ++s) q[s] = *(const bf16x8*)(T + r32 * 128 + (((2 * s + h) ^ (r32 & 7)) << 4));
#pragma unroll
    for (int k = 0; k < 4; ++k) { const int rr = (lane >> 3) + 8 * k, c = lane & 7; *(u32x4*)(T + rr * 128 + ((c ^ (rr & 7)) << 4)) = gv[k]; }
}
template <class DstF> DI void store_gated(unsigned char* T, const f32x16 (&o)[2], float mul, int lane, DstF dstrow) {
    const int r32 = lane & 31, h = lane >> 5;
#pragma unroll
    for (int nt = 0; nt < 2; ++nt)
#pragma unroll
        for (int qd = 0; qd < 4; ++qd) {
            unsigned char* a = T + r32 * 128 + (((4 * nt + qd) ^ (r32 & 7)) << 4) + 8 * h;
            const u32x2 g = *(const u32x2*)a;
            u32x2 w; w.x = pack2(o[nt][4 * qd] * mul * bflo(g.x), o[nt][4 * qd + 1] * mul * bfhi(g.x)); w.y = pack2(o[nt][4 * qd + 2] * mul * bflo(g.y), o[nt][4 * qd + 3] * mul * bfhi(g.y));
            *(u32x2*)a = w;
        }
    tile_to_rows(T, lane, dstrow);
}

template <class SrcF, class CompF>
DI void tile_loop(unsigned char* lds, int n, int tid, SrcF src, CompF comp) {
    u16* K0 = (u16*)lds; u16* V0 = K0 + 64 * GP; u16* K1 = (u16*)(lds + 18432); u16* V1 = K1 + 64 * GP;
    u32x4 rk[2], rv[2];
    { const TileSrc s0 = src(0); tile_load(s0, rk[0], rv[0], tid); }
    { const TileSrc s1 = src(n > 1 ? 1 : 0); tile_load(s1, rk[1], rv[1], tid); }
    LBAR();
    tile_store(K0, V0, rk[0], rv[0], tid);
    LBAR();
    for (int i2 = 0; i2 < n; i2 += 2) {
#pragma unroll
        for (int j = 0; j < 2; ++j) {
            const int i = i2 + j;
            { const int nx = i + 2 < n ? i + 2 : n - 1; const TileSrc s2 = src(nx); tile_load(s2, rk[j], rv[j], tid); }
            __builtin_amdgcn_sched_barrier(0);
            if (i < n) comp(i, j ? K1 : K0, j ? V1 : V0);
            __builtin_amdgcn_sched_barrier(0);
            tile_store(j ? K0 : K1, j ? V0 : V1, rk[j ^ 1], rv[j ^ 1], tid);
            LBAR();
        }
    }
}

DI void item_swa(const Params& p, unsigned char* lds, int item) {
    const u16* Z = (const u16*)(p.ws + OFF_Z); u16* MIX = (u16*)(p.ws + OFF_MIX);
    const int tid = tid_(), wid = tid >> 6, lane = tid & 63, r32 = lane & 31;
    const int qt = item & 31, kvh = (item >> 5) & 1, b = item >> 6;
    const int tok = 64 * qt + 8 * wid + (r32 >> 2), head = 4 * kvh + (r32 & 3);
    const size_t row = (size_t)b * SEQ + tok;
    unsigned char* WT = wtile(lds, wid);
    const size_t rowb = (size_t)b * SEQ + 64 * qt + 8 * wid;
    bf16x8 q[4]; load_q(WT, q, lane, [&](int rr) { return Z + (rowb + (rr >> 2)) * LDZ0 + 64 * (4 * kvh + (rr & 3)); },
                        [&](int rr) { return Z + (rowb + (rr >> 2)) * LDZ0 + 768 + 64 * (4 * kvh + (rr & 3)); });
    AttnAcc st; attn_reset(st);
    const int kt0 = qt >= 2 ? qt - 2 : 0;
    tile_loop(lds, qt - kt0 + 1, tid,
        [&](int i) { const u16* zb = Z + ((size_t)b * SEQ + 64 * (kt0 + i)) * LDZ0; return TileSrc{zb + 512 + 64 * kvh, zb + 640 + 64 * kvh, LDZ0, LDZ0}; },
        [&](int i, const u16* Kt, const u16* Vt) {
            const int kt = kt0 + i, base = 64 * kt;
            if (kt == qt - 1) attn_compute<1>(Kt, Vt, q, st, lane, true, [&](int) { return true; });
            else attn_compute<0>(Kt, Vt, q, st, lane, true, [&](int kl) { const int s = base + kl; return s <= tok && s > tok - 128; });
        });
    const float sink = p.in[11][head];
    const float denom = st.l + ex2(sink * LOG2E - st.m);
    store_gated(WT, st.o, 1.f / denom, lane, [&](int rr) { return MIX + (rowb + (rr >> 2)) * LDMIX + 64 * (4 * kvh + (rr & 3)); });
}

DI void item_mem(const Params& p, unsigned char* lds, int item, int layer) {
    const u16* Z = (const u16*)(p.ws + OFF_Z); u16* MIX = (u16*)(p.ws + OFF_MIX);
    const u16* MKV = (const u16*)(p.ws + OFF_MKV) + (size_t)layer * 8192 * 512;
    const int ldz = layer ? LDZ1 : LDZ0, qcol = layer ? 3840 : 2304, gcol = layer ? 4096 : 2560;
    const int tid = tid_(), wid = tid >> 6, lane = tid & 63, r32 = lane & 31;
    const int tile = item & 7, head = (item >> 3) & 3, b = item >> 5;
    const int tok = 256 * tile + 32 * wid + r32;
    const size_t row = (size_t)b * SEQ + tok;
    unsigned char* WT = wtile(lds, wid);
    const size_t rowb = (size_t)b * SEQ + 256 * tile + 32 * wid;
    const u16* kb = MKV + (size_t)(b * 256) * 512 + 64 * head;
    u32x4 rk[4], rv[4];
#pragma unroll
    for (int t = 0; t < 4; ++t) { const TileSrc ts{kb + (size_t)(64 * t) * 512, kb + (size_t)(64 * t) * 512 + 256, 512, 512}; tile_load(ts, rk[t], rv[t], tid); }
    bf16x8 q[4]; load_q(WT, q, lane, [&](int rr) { return Z + (rowb + rr) * ldz + qcol + 64 * head; }, [&](int rr) { return Z + (rowb + rr) * ldz + gcol + 64 * head; });
    AttnAcc st; attn_reset(st);
    LBAR();
#pragma unroll
    for (int t = 0; t < 4; ++t) tile_store((u16*)(lds + 18432 * t), (u16*)(lds + 18432 * t) + 64 * GP, rk[t], rv[t], tid);
    LBAR();
#pragma unroll 1
    for (int t = 0; t < 4; ++t) { const u16* kt = (const u16*)(lds + 18432 * t); attn_compute<1>(kt, kt + 64 * GP, q, st, lane, true, [&](int) { return true; }); }
    store_gated(WT, st.o, 1.f / st.l, lane, [&](int rr) { return MIX + (rowb + rr) * LDMIX + 1024 + 64 * head; });
}

DI void item_nsa(const Params& p, unsigned char* lds, int item) {
    const u16* Z = (const u16*)(p.ws + OFF_Z); u16* MIX = (u16*)(p.ws + OFF_MIX);
    const u16* KC = (const u16*)(p.ws + OFF_KC); const u16* VC = (const u16*)(p.ws + OFF_VC);
    u16* Kc = (u16*)(lds + 36864); u16* Vtc = (u16*)(lds + 55296);
    float* pc4 = (float*)(lds + 73728); float* pl = (float*)(lds + 82432);
    unsigned* selm = (unsigned*)(lds + 91136); unsigned* umw = (unsigned*)(lds + 91392);
    const int tid = tid_(), wid = tid >> 6, lane = tid & 63, r32 = lane & 31, h = lane >> 5;
    const int qt = 31 - (item >> 6), kvh = item & 1, b = (item >> 1) & 31;
    const int ttl = 8 * wid + (r32 >> 2);
    const int tok = 64 * qt + ttl, head = 4 * kvh + (r32 & 3);
    const size_t row = (size_t)b * SEQ + tok;
    const u16* zrow = Z + row * LDZ1;
    unsigned char* WT = wtile(lds, wid);
    const size_t rowb = (size_t)b * SEQ + 64 * qt + 8 * wid;
    bf16x8 q[4]; load_q(WT, q, lane, [&](int rr) { return Z + (rowb + (rr >> 2)) * LDZ1 + 2048 + 64 * (4 * kvh + (rr & 3)); },
                        [&](int rr) { return Z + (rowb + (rr >> 2)) * LDZ1 + 3328 + 64 * (4 * kvh + (rr & 3)); });
    float gcmp, gsel, gwin;
    { const u16* gp = zrow + 4352 + 3 * head; gcmp = bf2f(gp[0]); gsel = bf2f(gp[1]); gwin = bf2f(gp[2]); }
    f32x16 osum[2];
    {
        const u16* kcb = KC + ((size_t)(b * 128) * 2 + kvh) * 64; const u16* vcb = VC + ((size_t)(b * 128) * 2 + kvh) * 64;
        u32x4 ck[2], cv[2];
#pragma unroll
        for (int i = 0; i < 2; ++i) {
            ck[i] = *(const u32x4*)(kcb + (size_t)((tid >> 3) + 64 * i) * 128 + (tid & 7) * 8);
            cv[i] = *(const u32x4*)(vcb + (size_t)((tid >> 3) + 64 * i) * 128 + (tid & 7) * 8);
        }
        __syncthreads();
#pragma unroll
        for (int i = 0; i < 2; ++i) {
            const int key = (tid >> 3) + 64 * i;
            *(u32x4*)(Kc + key * GP + (tid & 7) * 8) = ck[i];
            *(u32x4*)(Vtc + key * GP + (tid & 7) * 8) = cv[i];
        }
    }
    __syncthreads();
    {
        f32x16 X[4];
#pragma unroll
        for (int k4 = 0; k4 < 4; ++k4) {
#pragma unroll
            for (int i = 0; i < 16; ++i) X[k4][i] = 0.f;
#pragma unroll
            for (int s = 0; s < 4; ++s) { const bf16x8 kf = *(const bf16x8*)(Kc + (32 * k4 + r32) * GP + 16 * s + 8 * h); X[k4] = MFMA32(kf, q[s], X[k4]); }
        }
        const int nmax = tok >= 31 ? ((tok - 31) >> 4) : -1;
        float mx = -1e30f;
#pragma unroll
        for (int k4 = 0; k4 < 4; ++k4)
#pragma unroll
            for (int reg = 0; reg < 16; ++reg) { const int n = 32 * k4 + (reg & 3) + 8 * (reg >> 2) + 4 * h; float t = X[k4][reg] * SC_LOG2; t = n <= nmax ? t : -1e30f; X[k4][reg] = t; mx = fmaxf(mx, t); }
        mx = xor32_max(mx);
        float rsum = 0.f;
#pragma unroll
        for (int k4 = 0; k4 < 4; ++k4)
#pragma unroll
            for (int reg = 0; reg < 16; ++reg) { const float t = X[k4][reg]; const float pv = t > -1e29f ? ex2(t - mx) : 0.f; X[k4][reg] = pv; rsum += pv; }
        rsum = xor32_sum(rsum);
        const float inv = rsum > 0.f ? 1.f / rsum : 0.f;
#pragma unroll
        for (int k4 = 0; k4 < 4; ++k4)
#pragma unroll
            for (int reg = 0; reg < 16; ++reg) X[k4][reg] *= inv;
#pragma unroll
        for (int k4 = 0; k4 < 4; ++k4)
#pragma unroll
            for (int q4 = 0; q4 < 4; ++q4) {
                float s4 = (X[k4][4 * q4] + X[k4][4 * q4 + 1]) + (X[k4][4 * q4 + 2] + X[k4][4 * q4 + 3]);
                float lt = X[k4][4 * q4 + 3];
                s4 = quad_sum(s4); lt = quad_sum(lt);
                if ((r32 & 3) == 0) { const int j = 8 * k4 + 2 * q4 + h; pc4[ttl * 33 + j] = s4; pl[ttl * 33 + j] = lt; }
            }
        f32x16 o[2];
#pragma unroll
        for (int i = 0; i < 16; ++i) { o[0][i] = 0.f; o[1][i] = 0.f; }
#pragma unroll
        for (int k4 = 0; k4 < 4; ++k4)
#pragma unroll
            for (int s = 0; s < 2; ++s) {
                u32x4 w; w.x = pack2(X[k4][8 * s], X[k4][8 * s + 1]); w.y = pack2(X[k4][8 * s + 2], X[k4][8 * s + 3]);
                w.z = pack2(X[k4][8 * s + 4], X[k4][8 * s + 5]); w.w = pack2(X[k4][8 * s + 6], X[k4][8 * s + 7]);
                const bf16x8 pf = __builtin_bit_cast(bf16x8, w);
#pragma unroll
                for (int nt = 0; nt < 2; ++nt) {
                    const u16* vp = Vtc + (32 * k4 + 16 * s + 4 * h + ((lane & 15) >> 2)) * GP + 32 * nt + 16 * ((lane >> 4) & 1) + 4 * (lane & 3);
                    const s16x4 lo = tr_read(vp), hi = tr_read(vp + 8 * GP);
                    const bf16x8 vf = __builtin_shufflevector(lo, hi, 0, 1, 2, 3, 4, 5, 6, 7);
                    o[nt] = MFMA32(vf, pf, o[nt]);
                }
            }
#pragma unroll
        for (int i = 0; i < 16; ++i) { osum[0][i] = o[0][i] * gcmp; osum[1][i] = o[1][i] * gcmp; }
    }
    __syncthreads();
    if (tid < 64) {
        const int cur = qt;
        unsigned mask = 1u | (1u << cur);
        const int npick = 2;
        if (cur >= 2) {
            int p1 = -1, p2 = -1; float b1 = -1.f, b2 = -1.f;
            for (int j = 1; j < cur; ++j) {
                const float v = pc4[tid * 33 + j] + pl[tid * 33 + j - 1];
                if (v > b1) { b2 = b1; p2 = p1; b1 = v; p1 = j; }
                else if (v > b2) { b2 = v; p2 = j; }
            }
            if (p1 >= 0) mask |= 1u << p1;
            if (p2 >= 0) mask |= 1u << p2;
        }
        selm[tid] = mask;
        unsigned um = mask;
#pragma unroll
        for (int o = 1; o < 64; o <<= 1) um |= (unsigned)__shfl_xor((int)um, o);
        if (tid == 0) umw[0] = um;
    }
    __syncthreads();
    const unsigned sm = selm[ttl];
    unsigned um = umw[0];
    {
        AttnAcc st; attn_reset(st);
        const int ntile = __builtin_popcount(um);
        unsigned rem_src = um, rem_cmp = um; int kt_src = 0;
        tile_loop(lds, ntile, tid,
            [&](int) { if (rem_src) { kt_src = __builtin_ctz(rem_src); rem_src &= rem_src - 1; } const int kt = kt_src; const u16* zb = Z + ((size_t)b * SEQ + 64 * kt) * LDZ1; return TileSrc{zb + 2816 + 64 * kvh, zb + 2944 + 64 * kvh, LDZ1, LDZ1}; },
            [&](int, const u16* Kt, const u16* Vt) {
                const int ktc = __builtin_ctz(rem_cmp); rem_cmp &= rem_cmp - 1;
                const int kt = ktc, base = 64 * kt; const bool on = (sm >> kt) & 1u;
                if (__any(on)) {
                    if (kt < qt) attn_compute<2>(Kt, Vt, q, st, lane, on, [&](int) { return true; });
                    else attn_compute<0>(Kt, Vt, q, st, lane, true, [&](int kl) { return on && (base + kl <= tok); });
                }
            });
        const float mul = gsel / st.l;
#pragma unroll
        for (int i = 0; i < 16; ++i) { osum[0][i] += st.o[0][i] * mul; osum[1][i] += st.o[1][i] * mul; }
    }
    {
        AttnAcc st; attn_reset(st);
        const int kt0 = qt >= 8 ? qt - 8 : 0;
        tile_loop(lds, qt - kt0 + 1, tid,
            [&](int i) { const u16* zb = Z + ((size_t)b * SEQ + 64 * (kt0 + i)) * LDZ1; return TileSrc{zb + 3072 + 64 * kvh, zb + 3200 + 64 * kvh, LDZ1, LDZ1}; },
            [&](int i, const u16* Kt, const u16* Vt) {
                const int kt = kt0 + i, base = 64 * kt;
                if (kt < qt && kt > qt - 8) attn_compute<1>(Kt, Vt, q, st, lane, true, [&](int) { return true; });
                else attn_compute<0>(Kt, Vt, q, st, lane, true, [&](int kl) { const int s = base + kl; return s <= tok && s > tok - 512; });
            });
        const float mul = gwin / st.l;
#pragma unroll
        for (int i = 0; i < 16; ++i) { osum[0][i] += st.o[0][i] * mul; osum[1][i] += st.o[1][i] * mul; }
    }
    store_gated(WT, osum, 1.f, lane, [&](int rr) { return MIX + (rowb + (rr >> 2)) * LDMIX + 512 + 64 * (4 * kvh + (rr & 3)); });
}

DI void item_rglru(const Params& p, unsigned char* lds, int item) {
    const u16* Z = (const u16*)(p.ws + OFF_Z); u16* MIX = (u16*)(p.ws + OFF_MIX);
    float* Xs = (float*)lds;
    float* XC = (float*)(lds + 17152);
    u16* XCb = (u16*)(lds + 34560);
    u16* WrT = (u16*)(lds + 43776); u16* WiT = (u16*)(lds + 52992);
    float* Aa = (float*)(lds + 62208); float* Uu = (float*)(lds + 78592);
    u16* Gs = (u16*)(lds + 94976);
    float* segA = (float*)(lds + 103168); float* segB = (float*)(lds + 105216);
    float* carry = (float*)(lds + 107264);
    const int tid = tid_(), wid = tid >> 6, lane = tid & 63, fr = lane & 15, fq = lane >> 4;
    const int hb = item & 7, b = item >> 3;
    __syncthreads();
    {
        const float* wr = p.in[14] + (size_t)hb * 4096; const float* wi = p.in[16] + (size_t)hb * 4096;
#pragma unroll
        for (int e = 0; e < 8; ++e) { const int idx = tid + 512 * e, i = idx >> 6, j = idx & 63; WrT[j * GP + i] = f2bf(wr[idx]); WiT[j * GP + i] = f2bf(wi[idx]); }
        if (tid < 192) Xs[tid] = 0.f;
        if (tid < 64) carry[tid] = 0.f;
    }
    const int ct = tid >> 3, cc8 = (tid & 7) * 8;
    float cw[4][8], cb[8];
#pragma unroll
    for (int e = 0; e < 8; ++e) {
        cb[e] = p.in[13][64 * hb + cc8 + e];
#pragma unroll
        for (int j = 0; j < 4; ++j) cw[j][e] = p.in[12][j * 512 + 64 * hb + cc8 + e];
    }
    const int jt = wid & 3, tpair = wid >> 2;
    float sp[4], br[4], bi[4];
#pragma unroll
    for (int r = 0; r < 4; ++r) {
        const int c = 64 * hb + 16 * jt + 4 * fq + r;
        const float lam = p.in[18][c];
        sp[r] = log1pf(expf(-lam)); br[r] = p.in[15][c]; bi[r] = p.in[17][c];
    }
    const size_t zrow0 = (size_t)b * SEQ;
    u32x4 rx = *(const u32x4*)(Z + (zrow0 + ct) * LDZ0 + 1280 + 64 * hb + cc8);
    u32x4 rg = *(const u32x4*)(Z + (zrow0 + ct) * LDZ0 + 1792 + 64 * hb + cc8);
    for (int c = 0; c < 32; ++c) {
        {
            float* xr = Xs + (3 + ct) * 64 + cc8;
            *(f32x4*)xr = (f32x4){bflo(rx.x), bfhi(rx.x), bflo(rx.y), bfhi(rx.y)};
            *(f32x4*)(xr + 4) = (f32x4){bflo(rx.z), bfhi(rx.z), bflo(rx.w), bfhi(rx.w)};
            *(u32x4*)(Gs + ct * 64 + cc8) = rg;
        }
        LBAR();
        {
            const int cn = c + 1 < 32 ? c + 1 : 31;
            rx = *(const u32x4*)(Z + (zrow0 + 64 * cn + ct) * LDZ0 + 1280 + 64 * hb + cc8);
            rg = *(const u32x4*)(Z + (zrow0 + 64 * cn + ct) * LDZ0 + 1792 + 64 * hb + cc8);
        }
        __builtin_amdgcn_sched_barrier(0);
        {
            float xc[8];
#pragma unroll
            for (int e = 0; e < 8; ++e) xc[e] = cb[e];
#pragma unroll
            for (int j = 0; j < 4; ++j) {
                const f32x4 a = *(const f32x4*)(Xs + (ct + j) * 64 + cc8), bb = *(const f32x4*)(Xs + (ct + j) * 64 + cc8 + 4);
#pragma unroll
                for (int e = 0; e < 4; ++e) { xc[e] += cw[j][e] * a[e]; xc[4 + e] += cw[j][4 + e] * bb[e]; }
            }
            *(f32x4*)(XC + ct * 68 + cc8) = (f32x4){xc[0], xc[1], xc[2], xc[3]};
            *(f32x4*)(XC + ct * 68 + cc8 + 4) = (f32x4){xc[4], xc[5], xc[6], xc[7]};
            u32x4 w; w.x = pack2(xc[0], xc[1]); w.y = pack2(xc[2], xc[3]); w.z = pack2(xc[4], xc[5]); w.w = pack2(xc[6], xc[7]);
            *(u32x4*)(XCb + ct * GP + cc8) = w;
        }
        LBAR();
        {
#pragma unroll
            for (int ts = 0; ts < 2; ++ts) {
                const int tt = 2 * tpair + ts;
                f32x4 accr = {0.f, 0.f, 0.f, 0.f}, acci = {0.f, 0.f, 0.f, 0.f};
#pragma unroll
                for (int ks = 0; ks < 2; ++ks) {
                    const bf16x8 ar = *(const bf16x8*)(WrT + (16 * jt + fr) * GP + 32 * ks + 8 * fq);
                    const bf16x8 ai = *(const bf16x8*)(WiT + (16 * jt + fr) * GP + 32 * ks + 8 * fq);
                    const bf16x8 bx = *(const bf16x8*)(XCb + (16 * tt + fr) * GP + 32 * ks + 8 * fq);
                    accr = MFMA16(ar, bx, accr); acci = MFMA16(ai, bx, acci);
                }
                const int t = 16 * tt + fr;
                const f32x4 xc4 = *(const f32x4*)(XC + t * 68 + 16 * jt + 4 * fq);
                f32x4 av, uv;
#pragma unroll
                for (int r = 0; r < 4; ++r) {
                    const float rgate = sigmoidf_(accr[r] + br[r]), igate = sigmoidf_(acci[r] + bi[r]);
                    const float la = -8.f * rgate * sp[r];
                    av[r] = __expf(la); uv[r] = __builtin_amdgcn_sqrtf(fmaxf(1.f - __expf(2.f * la), 0.f)) * igate * xc4[r];
                }
                *(f32x4*)(Aa + t * 64 + 16 * jt + 4 * fq) = av; *(f32x4*)(Uu + t * 64 + 16 * jt + 4 * fq) = uv;
            }
            if (tid < 192) Xs[tid] = Xs[64 * 64 + tid];
        }
        LBAR();
        const int ch = tid & 63, seg = tid >> 6;
        float av8[8], uv8[8];
        {
            float A = 1.f, B = 0.f;
#pragma unroll
            for (int i = 0; i < 8; ++i) { av8[i] = Aa[(8 * seg + i) * 64 + ch]; uv8[i] = Uu[(8 * seg + i) * 64 + ch]; B = av8[i] * B + uv8[i]; A *= av8[i]; }
            segA[seg * 64 + ch] = A; segB[seg * 64 + ch] = B;
        }
        LBAR();
        {
            float hst = carry[(c & 1) * 64 + ch];
#pragma unroll
            for (int s = 0; s < 7; ++s) if (s < seg) hst = segA[s * 64 + ch] * hst + segB[s * 64 + ch];
#pragma unroll
            for (int i = 0; i < 8; ++i) {
                hst = av8[i] * hst + uv8[i];
                const int t = 8 * seg + i;
                MIX[(zrow0 + 64 * c + t) * LDMIX + 512 + 64 * hb + ch] = f2bf(hst * bf2f(Gs[t * 64 + ch]));
            }
            if (seg == 7) carry[((c + 1) & 1) * 64 + ch] = hst;
        }
        LBAR();
    }
}

DI void item_hgrn(const Params& p, unsigned char* lds, int item) {
    const u16* __restrict__ Z = (const u16*)(p.ws + OFF_Z); u16* __restrict__ MIX = (u16*)(p.ws + OFF_MIX);
    u16* Qs = (u16*)lds;
    u16* Ks = (u16*)(lds + 17408);
    u16* Vr = (u16*)(lds + 34816);
    u16* KhT = (u16*)(lds + 52224);
    u16* VT = (u16*)(lds + 70656);
    u16* As = (u16*)(lds + 89088);
    u16* ST = (u16*)(lds + 98304);
    float* qsum = (float*)(lds + 133120);
    float* dec = (float*)(lds + 135168);
    float* ssq = (float*)(lds + 135680);
    const int tid = tid_(), wid = tid >> 6, lane = tid & 63, fr = lane & 15, fq = lane >> 4;
    const int head = item & 3, b = item >> 2;
    const int d = tid & 127, qt = tid >> 7;
    const int lt = tid >> 3, lc = (tid & 7) * 16;
    __syncthreads();
    for (int i = tid; i < 128 * GP2 / 2; i += NTHR) ((unsigned*)ST)[i] = 0u;
    f32x4 sacc[8];
#pragma unroll
    for (int v = 0; v < 8; ++v) sacc[v] = (f32x4){0.f, 0.f, 0.f, 0.f};
    float og[4];
#pragma unroll
    for (int r = 0; r < 4; ++r) og[r] = p.in[22][16 * wid + 4 * fq + r];
    const size_t zrow0 = (size_t)b * SEQ;
    const int gcol = 1536 + 128 * head + 16 * wid + 4 * fq;
    u32x4 rq[2], rg[2], rv[2]; u32x2 gn[4];
    {
        const u16* zp = Z + (zrow0 + lt) * LDZ1 + 128 * head + lc;
        rq[0] = *(const u32x4*)zp; rq[1] = *(const u32x4*)(zp + 8);
        rg[0] = *(const u32x4*)(zp + 512); rg[1] = *(const u32x4*)(zp + 520);
        rv[0] = *(const u32x4*)(zp + 1024); rv[1] = *(const u32x4*)(zp + 1032);
#pragma unroll
        for (int tt = 0; tt < 4; ++tt) gn[tt] = *(const u32x2*)(Z + (zrow0 + 16 * tt + fr) * LDZ1 + gcol);
    }
    for (int c = 0; c < 32; ++c) {
        u32x2 gc[4];
        {
            *(u32x4*)(Qs + lt * GP2 + lc) = rq[0]; *(u32x4*)(Qs + lt * GP2 + lc + 8) = rq[1];
            *(u32x4*)(Ks + lt * GP2 + lc) = rg[0]; *(u32x4*)(Ks + lt * GP2 + lc + 8) = rg[1];
            *(u32x4*)(Vr + lt * GP2 + lc) = rv[0]; *(u32x4*)(Vr + lt * GP2 + lc + 8) = rv[1];
#pragma unroll
            for (int tt = 0; tt < 4; ++tt) gc[tt] = gn[tt];
        }
        LBAR();
        {
            const int cn = c + 1 < 32 ? c + 1 : 31;
            const u16* zp = Z + (zrow0 + 64 * cn + lt) * LDZ1 + 128 * head + lc;
            rq[0] = *(const u32x4*)zp; rq[1] = *(const u32x4*)(zp + 8);
            rg[0] = *(const u32x4*)(zp + 512); rg[1] = *(const u32x4*)(zp + 520);
            rv[0] = *(const u32x4*)(zp + 1024); rv[1] = *(const u32x4*)(zp + 1032);
#pragma unroll
            for (int tt = 0; tt < 4; ++tt) gn[tt] = *(const u32x2*)(Z + (zrow0 + 64 * cn + 16 * tt + fr) * LDZ1 + gcol);
        }
        __builtin_amdgcn_sched_barrier(0);
        float bl[16], gv[16];
        {
            float run = 0.f;
#pragma unroll
            for (int i = 0; i < 16; ++i) { gv[i] = bf2f(Ks[(16 * qt + i) * GP2 + d]); run += gv[i]; bl[i] = run; }
            qsum[qt * 128 + d] = run;
        }
        LBAR();
        {
            float off = 0.f, tot = 0.f;
#pragma unroll
            for (int qq = 0; qq < 4; ++qq) { const float s = qsum[qq * 128 + d]; tot += s; if (qq < qt) off += s; }
            unsigned khw[8], vw[8];
#pragma unroll
            for (int i2 = 0; i2 < 8; ++i2) {
                float kh[2], vv[2];
#pragma unroll
                for (int e = 0; e < 2; ++e) {
                    const int i = 2 * i2 + e;
                    const float bb = off + bl[i];
                    const float kk = 1.f - __expf(gv[i]);
                    const float qv = bf2f(Qs[(16 * qt + i) * GP2 + d]);
                    vv[e] = bf2f(Vr[(16 * qt + i) * GP2 + d]);
                    Qs[(16 * qt + i) * GP2 + d] = f2bf(qv * __expf(bb));
                    Ks[(16 * qt + i) * GP2 + d] = f2bf(kk * __expf(fminf(-bb, 80.f)));
                    kh[e] = kk * __expf(tot - bb);
                }
                khw[i2] = pack2(kh[0], kh[1]); vw[i2] = pack2(vv[0], vv[1]);
            }
            *(u32x4*)(KhT + d * GP + 16 * qt) = (u32x4){khw[0], khw[1], khw[2], khw[3]};
            *(u32x4*)(KhT + d * GP + 16 * qt + 8) = (u32x4){khw[4], khw[5], khw[6], khw[7]};
            *(u32x4*)(VT + d * GP + 16 * qt) = (u32x4){vw[0], vw[1], vw[2], vw[3]};
            *(u32x4*)(VT + d * GP + 16 * qt + 8) = (u32x4){vw[4], vw[5], vw[6], vw[7]};
            if (qt == 0) dec[d] = __expf(tot);
        }
        LBAR();
        {
            const int st = wid >> 1;
#pragma unroll
            for (int ts = 0; ts < 2; ++ts) {
                const int tt = 2 * (wid & 1) + ts;
                f32x4 acc = {0.f, 0.f, 0.f, 0.f};
                if (st <= tt) {
#pragma unroll
                    for (int ks = 0; ks < 4; ++ks) {
                        const bf16x8 a = *(const bf16x8*)(Ks + (16 * st + fr) * GP2 + 32 * ks + 8 * fq);
                        const bf16x8 bq = *(const bf16x8*)(Qs + (16 * tt + fr) * GP2 + 32 * ks + 8 * fq);
                        acc = MFMA16(a, bq, acc);
                    }
                }
                const int t = 16 * tt + fr, s0 = 16 * st + 4 * fq;
                float a4[4];
#pragma unroll
                for (int r = 0; r < 4; ++r) a4[r] = (s0 + r <= t) ? acc[r] : 0.f;
                u32x2 w; w.x = pack2(a4[0], a4[1]); w.y = pack2(a4[2], a4[3]);
                *(u32x2*)(As + t * GP + s0) = w;
            }
        }
        LBAR();
        f32x4 oacc[4];
        {
#pragma unroll
            for (int tt = 0; tt < 4; ++tt) oacc[tt] = (f32x4){0.f, 0.f, 0.f, 0.f};
#pragma unroll
            for (int ks = 0; ks < 4; ++ks) {
                const bf16x8 a = *(const bf16x8*)(ST + (16 * wid + fr) * GP2 + 32 * ks + 8 * fq);
#pragma unroll
                for (int tt = 0; tt < 4; ++tt) { const bf16x8 bq = *(const bf16x8*)(Qs + (16 * tt + fr) * GP2 + 32 * ks + 8 * fq); oacc[tt] = MFMA16(a, bq, oacc[tt]); }
            }
#pragma unroll
            for (int ks = 0; ks < 2; ++ks) {
                const bf16x8 a = *(const bf16x8*)(VT + (16 * wid + fr) * GP + 32 * ks + 8 * fq);
#pragma unroll
                for (int tt = 0; tt < 4; ++tt) { const bf16x8 ba = *(const bf16x8*)(As + (16 * tt + fr) * GP + 32 * ks + 8 * fq); oacc[tt] = MFMA16(a, ba, oacc[tt]); }
            }
#pragma unroll
            for (int tt = 0; tt < 4; ++tt) {
                float s = oacc[tt][0] * oacc[tt][0] + oacc[tt][1] * oacc[tt][1] + oacc[tt][2] * oacc[tt][2] + oacc[tt][3] * oacc[tt][3];
                s = xor32_sum(xor16_sum(s));
                if (fq == 0) ssq[wid * 64 + 16 * tt + fr] = s;
            }
        }
        LBAR();
        {
#pragma unroll
            for (int tt = 0; tt < 4; ++tt) {
                const int t = 16 * tt + fr;
                float tot = 0.f;
#pragma unroll
                for (int w = 0; w < 8; ++w) tot += ssq[w * 64 + t];
                const float inv = rsqrtf(tot * (1.f / 128.f) + EPS);
                const size_t row = zrow0 + 64 * c + t;
                const u32x2 g = gc[tt];
                u32x2 w; w.x = pack2(oacc[tt][0] * inv * og[0] * bflo(g.x), oacc[tt][1] * inv * og[1] * bfhi(g.x));
                w.y = pack2(oacc[tt][2] * inv * og[2] * bflo(g.y), oacc[tt][3] * inv * og[3] * bfhi(g.y));
                *(u32x2*)(MIX + row * LDMIX + 128 * head + 16 * wid + 4 * fq) = w;
            }
            const f32x4 d4 = *(const f32x4*)(dec + 16 * wid + 4 * fq);
#pragma unroll
            for (int v = 0; v < 8; ++v) sacc[v] = sacc[v] * d4;
#pragma unroll
            for (int ks = 0; ks < 2; ++ks) {
                const bf16x8 a = *(const bf16x8*)(KhT + (16 * wid + fr) * GP + 32 * ks + 8 * fq);
#pragma unroll
                for (int v = 0; v < 8; ++v) { const bf16x8 bv = *(const bf16x8*)(VT + (16 * v + fr) * GP + 32 * ks + 8 * fq); sacc[v] = MFMA16(a, bv, sacc[v]); }
            }
#pragma unroll
            for (int v = 0; v < 8; ++v) { u32x2 w; w.x = pack2(sacc[v][0], sacc[v][1]); w.y = pack2(sacc[v][2], sacc[v][3]); *(u32x2*)(ST + (16 * v + fr) * GP2 + 16 * wid + 4 * fq) = w; }
        }
        LBAR();
    }
}

DI void phase_inproj(const Params& p, unsigned char* lds, int layer) {
    unsigned char* ws = p.ws;
    PG8_LAS unsigned char* l3 = (PG8_LAS unsigned char*)lds;
    const int NT = layer ? 18 : 11;
    EpiZ e; e.Z = (u16*)(ws + OFF_Z); e.ldz = layer ? LDZ1 : LDZ0; e.rs = (const float*)(ws + (layer ? OFF_RSP : OFF_RS0)); e.rs4 = (layer != 0); e.layer = layer; e.p = &p;
    e.cs = (const float*)(ws + OFF_COS); e.sn = (const float*)(ws + OFF_SIN); e.tr = lds + LDS_TR + 2048 * (tid_() >> 6);
    pg8::Gemm g{(const u16*)(ws + OFF_XB), (const u16*)(ws + (layer ? OFF_WT1 : OFF_WT0)), DM};
    pg8::SchedIn S{NT, (int)(gridDim.x >> 3), (int)(blockIdx.x >> 3), (int)(blockIdx.x & 7)};
    pg8::gemm_phase<EpiZ, pg8::SchedIn, true>(l3, g, S, e);
    if (layer == 0) {
        for (int u = blockIdx.x; u < 128; u += gridDim.x) {
            const int l = u >> 6, pm = (u >> 1) & 31, pn = u & 1;
            EpiZ em; em.Z = (u16*)(ws + OFF_MKV) + (size_t)l * 8192 * 512; em.ldz = 512; em.rs = (const float*)(ws + OFF_RSM); em.layer = 2 + l; em.p = &p; em.cs = e.cs; em.sn = e.sn; em.tr = e.tr; em.rs4 = false;
            pg8::Gemm gm{(const u16*)(ws + OFF_MEMB), (const u16*)(ws + OFF_WM) + (size_t)l * 512 * 1024, DM};
            pg8::SchedOne S1{pm, pn, true};
            pg8::gemm_phase<EpiZ, pg8::SchedOne, false>(l3, gm, S1, em);
        }
        if (gridDim.x > 128) { if (blockIdx.x >= 128) prep_layer1(p, lds, blockIdx.x - 128, gridDim.x - 128); }
        else prep_layer1(p, lds, blockIdx.x, gridDim.x);
    }
}

DI void phase_outproj(const Params& p, unsigned char* lds, int layer) {
    unsigned char* ws = p.ws;
    PG8_LAS unsigned char* l3 = (PG8_LAS unsigned char*)lds;
    pg8::Gemm g{(const u16*)(ws + OFF_MIX), (const u16*)(ws + (layer ? OFF_WO1 : OFF_WO0)), LDMIX};
    const int tid = tid_();
    if (layer == 0) {
        EpiOut0 e; e.x = p.in[0]; e.out = p.out; e.xb = (u16*)(ws + OFF_XB); e.red = (float*)(lds + LDS_RED); e.tr = lds + LDS_TR + 2048 * (tid >> 6);
        e.rsp = (float*)(ws + OFF_RSP); e.par = 0; e.ppm = -1; e.ppn = 0;
        pg8::SchedOutX S{(int)(gridDim.x >> 3), (int)(blockIdx.x >> 3), (int)(blockIdx.x & 7)};
        pg8::gemm_phase<EpiOut0, pg8::SchedOutX, true>(l3, g, S, e);
        __syncthreads();
        { const int lane = tid & 63, wid = tid >> 6; e.flush(wid >> 2, wid & 3, lane & 15, lane >> 4); }
        __syncthreads();
    }
    if (layer == 1) {
        EpiOut1 e; e.out = p.out; e.xb = (const u16*)(ws + OFF_XB); e.tr = lds + LDS_TR + 2048 * (tid >> 6);
        pg8::SchedOutX S{(int)(gridDim.x >> 3), (int)(blockIdx.x >> 3), (int)(blockIdx.x & 7)};
        pg8::gemm_phase<EpiOut1, pg8::SchedOutX, true>(l3, g, S, e);
    }
}

DI void compress_unit(const Params& p, unsigned char* lds, int u) {
    unsigned char* ws = p.ws;
    const int kv = u & 1, pm = u >> 1;
    EpiCmp e; e.bias = (const float*)(ws + OFF_BIAS) + 128 * kv; e.w2 = kv ? p.in[32] : p.in[30]; e.gain = p.in[24]; e.dst = (u16*)(ws + (kv ? OFF_VC : OFF_KC)); e.isk = (kv == 0);
    e.cs = (const float*)(ws + OFF_COS); e.sn = (const float*)(ws + OFF_SIN);
    const u16* Zc = (const u16*)(ws + OFF_Z) + (kv ? 2688 : 2560);
    gemm_unit<EpiCmp, true>(lds, Zc, LDZ1, 0, (const u16*)(ws + (kv ? OFF_W1V : OFF_W1K)), 2048, 32, pm, 0, e);
}

DI void phase_mix0(const Params& p, unsigned char* lds) {
    for (int it = blockIdx.x; it < 256; it += gridDim.x) item_rglru(p, lds, it);
    for (int it = blockIdx.x; it < 2048; it += gridDim.x) item_swa(p, lds, it);
    for (int it = blockIdx.x; it < 1024; it += gridDim.x) item_mem(p, lds, it, 0);
}

__shared__ int s_ticket;
DI void phase_mix1(const Params& p, unsigned char* lds, int ci) {
    unsigned* ctr = (unsigned*)(p.ws + OFF_CTR) + ci;
    bool cmp_ready = false;
    unsigned nxt = 0;
    if (threadIdx.x == 0) nxt = atomicAdd(ctr, 1u);
    for (;;) {
        __syncthreads();
        if (threadIdx.x == 0) { s_ticket = (int)nxt; nxt = atomicAdd(ctr, 1u); }
        __syncthreads();
        const int tk = s_ticket;
        if (tk >= 128 + 64 + 1024 + 2048) break;
        if (tk < 128) item_hgrn(p, lds, tk);
        else if (tk < 192) {
            compress_unit(p, lds, tk - 128);
            __threadfence(); __syncthreads();
            if (threadIdx.x == 0) atomicAdd(ctr + 8, 1u);
        }
        else if (tk < 192 + 1024) item_mem(p, lds, tk - 192, 1);
        else {
            if (!cmp_ready) {
                if (threadIdx.x == 0) { while (__hip_atomic_load(ctr + 8, __ATOMIC_RELAXED, __HIP_MEMORY_SCOPE_AGENT) < 64u) __builtin_amdgcn_s_sleep(8); }
                __syncthreads(); __threadfence(); cmp_ready = true;
            }
            item_nsa(p, lds, tk - 192 - 1024);
        }
    }
}


DI void gbar(unsigned* bar, unsigned k) {
    __syncthreads();
    if (threadIdx.x == 0) {
        __builtin_amdgcn_fence(__ATOMIC_RELEASE, "agent"); asm volatile("s_waitcnt vmcnt(0)" ::: "memory");
        atomicAdd(bar, 1u);
        const unsigned target = k * gridDim.x;
        while (__hip_atomic_load(bar, __ATOMIC_RELAXED, __HIP_MEMORY_SCOPE_AGENT) < target) __builtin_amdgcn_s_sleep(2);
        __builtin_amdgcn_fence(__ATOMIC_ACQUIRE, "agent"); asm volatile("s_waitcnt vmcnt(0)" ::: "memory");
    }
    __syncthreads();
}

constexpr int NPHASE = 8;
__global__ void __launch_bounds__(NTHR) mega(Params p) {
    extern __shared__ __attribute__((aligned(16))) unsigned char lds[];
    cg::grid_group grid = cg::this_grid();
#ifndef PROBE_MASK
#define PROBE_MASK 0
#endif
    unsigned* bar = (unsigned*)(p.ws + OFF_BAR); unsigned nbar = 0;
#define PH(k, call0, call1) if (p.ph_lo <= (k) && (k) < p.ph_hi) { call0; if ((PROBE_MASK >> (k)) & 1) { grid.sync(); call1; } if ((k) + 1 < p.ph_hi) { if ((k) == 0) grid.sync(); else gbar(bar, ++nbar); } }
    PH(0, phase_prep(p, lds), phase_prep(p, lds))
    PH(1, phase_inproj(p, lds, 0), phase_inproj(p, lds, 0))
    PH(2, phase_mix0(p, lds), phase_mix0(p, lds))
    PH(3, phase_outproj(p, lds, 0), phase_outproj(p, lds, 0))
    PH(4, phase_inproj(p, lds, 1), phase_inproj(p, lds, 1))
    PH(6, phase_mix1(p, lds, 0), phase_mix1(p, lds, 1))
    PH(7, phase_outproj(p, lds, 1), phase_outproj(p, lds, 1))
#undef PH
}

extern "C" void kernel_launch(void* const* d_in, const int* in_sizes, int n_in, void* d_out, int out_size, void* d_ws, size_t ws_size, hipStream_t stream) {
    static int grid = 0;
    if (grid == 0) {
        if (n_in != 33 || ws_size < WS_END) { fprintf(stderr, "kernel_launch: unexpected n_in %d / ws_size %zu (need %zu)\n", n_in, ws_size, (size_t)WS_END); grid = -1; return; }
        int dev = 0, cus = 0, per_cu = 0;
        hipGetDevice(&dev);
        hipDeviceGetAttribute(&cus, hipDeviceAttributeMultiprocessorCount, dev);
        if (hipFuncSetAttribute((const void*)mega, hipFuncAttributeMaxDynamicSharedMemorySize, LDS_BYTES) != hipSuccess) { fprintf(stderr, "kernel_launch: hipFuncSetAttribute failed\n"); grid = -1; return; }
        hipOccupancyMaxActiveBlocksPerMultiprocessor(&per_cu, (const void*)mega, NTHR, LDS_BYTES);
        if (per_cu < 1) { fprintf(stderr, "kernel_launch: occupancy query says %d blocks per CU\n", per_cu); per_cu = 1; }
        (void)hipGetLastError();
        grid = cus;
        if (grid % 8) grid -= grid % 8;
    }
    if (grid < 0) return;
    Params p{};
    for (int i = 0; i < 33; ++i) p.in[i] = (const float*)d_in[i];
    p.out = (float*)d_out; p.ws = (unsigned char*)d_ws;
#if ONE_LAUNCH
    p.ph_lo = 0; p.ph_hi = NPHASE;
    void* args[] = {&p};
    hipError_t e = hipLaunchCooperativeKernel((const void*)mega, dim3(grid), dim3(NTHR), args, LDS_BYTES, stream);
    if (e != hipSuccess) fprintf(stderr, "cooperative launch failed: %s (grid %d)\n", hipGetErrorString(e), grid);
#else
    for (int ph = 0; ph < NPHASE; ++ph) {
        p.ph_lo = ph; p.ph_hi = ph + 1;
        hipLaunchKernelGGL(mega, dim3(grid), dim3(NTHR), LDS_BYTES, stream, p);
    }
#endif
}
```

```cpp
#include <hip/hip_runtime.h>
#include <hip/hip_cooperative_groups.h>
#include <cstdio>
#include <cstdint>
namespace cg = cooperative_groups;

#ifndef ONE_LAUNCH
#define ONE_LAUNCH 1
#endif

#define DI __device__ __forceinline__
typedef unsigned short u16;
typedef short bf16x8 __attribute__((ext_vector_type(8)));
typedef short s16x4 __attribute__((ext_vector_type(4)));
typedef float f32x2 __attribute__((ext_vector_type(2)));
typedef float f32x4 __attribute__((ext_vector_type(4)));
typedef float f32x16 __attribute__((ext_vector_type(16)));
typedef unsigned u32x2 __attribute__((ext_vector_type(2)));
typedef unsigned u32x4 __attribute__((ext_vector_type(4)));
typedef __bf16 bf16x2_t __attribute__((ext_vector_type(2)));

DI unsigned pack2(float a, float b) { f32x2 v = {a, b}; bf16x2_t r = __builtin_convertvector(v, bf16x2_t); return __builtin_bit_cast(unsigned, r); }
DI u16 f2bf(float a) { return (u16)(pack2(a, 0.f) & 0xffffu); }
DI float bflo(unsigned w) { return __uint_as_float(w << 16); }
DI float bfhi(unsigned w) { return __uint_as_float(w & 0xffff0000u); }
DI float bf2f(u16 v) { return __uint_as_float(((unsigned)v) << 16); }
#define MFMA16(a, b, c) __builtin_amdgcn_mfma_f32_16x16x32_bf16((a), (b), (c), 0, 0, 0)
#define MFMA32(a, b, c) __builtin_amdgcn_mfma_f32_32x32x16_bf16((a), (b), (c), 0, 0, 0)
DI float rcpf_(float x) { return __builtin_amdgcn_rcpf(x); }
DI float sigmoidf_(float z) { return rcpf_(1.f + __expf(-z)); }
DI float siluf_(float z) { return z * rcpf_(1.f + __expf(-z)); }
DI float ex2(float x) { return __builtin_amdgcn_exp2f(x); }
DI float xor32_max(float x) { auto t = __builtin_amdgcn_permlane32_swap(__float_as_uint(x), __float_as_uint(x), false, false); return fmaxf(__uint_as_float(t[0]), __uint_as_float(t[1])); }
DI float xor32_sum(float x) { auto t = __builtin_amdgcn_permlane32_swap(__float_as_uint(x), __float_as_uint(x), false, false); return __uint_as_float(t[0]) + __uint_as_float(t[1]); }
DI float xor16_sum(float x) { auto t = __builtin_amdgcn_permlane16_swap(__float_as_uint(x), __float_as_uint(x), false, false); return __uint_as_float(t[0]) + __uint_as_float(t[1]); }
template <int CTRL> DI float dpp_(float x) { return __builtin_bit_cast(float, __builtin_amdgcn_mov_dpp(__builtin_bit_cast(int, x), CTRL, 0xf, 0xf, true)); }
DI float quad_sum(float x) { x += dpp_<0xB1>(x); x += dpp_<0x4E>(x); return x; }
DI int tid_() { int t = threadIdx.x; asm volatile("" : "+v"(t)); return t; }
#define CFENCE asm volatile("" ::: "memory")
#define LBAR() do { asm volatile("s_waitcnt lgkmcnt(0)" ::: "memory"); __builtin_amdgcn_s_barrier(); asm volatile("" ::: "memory"); } while (0)

constexpr int NTHR = 512;
constexpr int TOK = 65536, SEQ = 2048, NBATCH = 32, DM = 1024;
constexpr int LDZ0 = 2816, LDZ1 = 4608, LDMIX = 1280;
constexpr float EPS = 1e-6f;
constexpr float SC_LOG2 = 0.125f * 1.4426950408889634f;
constexpr float LOG2E = 1.4426950408889634f;

constexpr size_t OFF_WT0 = 0;
constexpr size_t OFF_WT1 = OFF_WT0 + (size_t)2816 * 1024 * 2;
constexpr size_t OFF_WO0 = OFF_WT1 + (size_t)4608 * 1024 * 2;
constexpr size_t OFF_WO1 = OFF_WO0 + (size_t)1024 * 1280 * 2;
constexpr size_t OFF_WM = OFF_WO1 + (size_t)1024 * 1280 * 2;
constexpr size_t OFF_W1K = OFF_WM + (size_t)2 * 512 * 1024 * 2;
constexpr size_t OFF_W1V = OFF_W1K + (size_t)256 * 2048 * 2;
constexpr size_t OFF_COS = OFF_W1V + (size_t)256 * 2048 * 2;
constexpr size_t OFF_SIN = OFF_COS + (size_t)2048 * 32 * 4;
constexpr size_t OFF_RS0 = OFF_SIN + (size_t)2048 * 32 * 4;
constexpr size_t OFF_RS1 = OFF_RS0 + (size_t)TOK * 4;
constexpr size_t OFF_RSM = OFF_RS1 + (size_t)TOK * 4;
constexpr size_t OFF_BIAS = OFF_RSM + (size_t)8192 * 4;
constexpr size_t OFF_CTR = OFF_BIAS + 1024;
constexpr size_t OFF_BAR = OFF_CTR + 512;
constexpr size_t OFF_KC = OFF_CTR + 1024;
constexpr size_t OFF_VC = OFF_KC + (size_t)32 * 128 * 128 * 2;
constexpr size_t OFF_MKV = OFF_VC + (size_t)32 * 128 * 128 * 2;
constexpr size_t OFF_MEMB = OFF_MKV + (size_t)2 * 8192 * 512 * 2;
constexpr size_t OFF_XB = OFF_MEMB + (size_t)8192 * 1024 * 2;
constexpr size_t OFF_MIX = OFF_XB + (size_t)TOK * 1024 * 2;
constexpr size_t OFF_Z = OFF_MIX + (size_t)TOK * 1280 * 2;
constexpr size_t OFF_RSP = OFF_Z + (size_t)TOK * 4608 * 2;
constexpr size_t WS_END = OFF_RSP + (size_t)4 * TOK * 4;

struct Params { const float* in[33]; float* out; unsigned char* ws; int ph_lo, ph_hi; };

constexpr int LDS_BYTES = 155776;
constexpr int LDS_TR = 131072, LDS_RED = 147456;
constexpr int GP = 72;
constexpr int GP2 = 136;

struct ALPlain { const u16* A; int lda; static constexpr int dummy = 0; int kstride;
    DI const u16* rowptr(int row) const { return A + (size_t)row * lda; } };
struct ALCmp { const u16* Zc; int kstride;
    DI const u16* rowptr(int row) const { return Zc; } };

template <class Epi, bool CMP>
DI void gemm_unit(unsigned char* lds, const u16* Abase, int lda, int kstrideA, const u16* Bt, int ldb, int nk, int pm, int pn, Epi& epi) {
    const int tid = tid_(), wid = tid >> 6, lane = tid & 63, fr = lane & 15, fq = lane >> 4;
    const int wm = wid >> 2, wn = wid & 3;
    u16* As = (u16*)lds; u16* Bs = As + 2 * 256 * GP;
    const int lrow = tid >> 3, lc8 = (tid & 7) * 8;
    const u16* ap0; const u16* bp0 = Bt + (size_t)(pn * 256 + lrow) * ldb + lc8;
    const size_t bstep = (size_t)64 * ldb;
    const int atok0 = 16 * (lrow >> 1);
    if (CMP) ap0 = Abase + (size_t)(pm * SEQ) * lda + 64 * (lrow & 1) + lc8;
    else ap0 = Abase + (size_t)(pm * 256 + lrow) * lda + lc8;
    const size_t astep = (size_t)64 * lda;
    f32x4 acc[8][4];
#pragma unroll
    for (int a = 0; a < 8; ++a)
#pragma unroll
        for (int b = 0; b < 4; ++b) acc[a][b] = (f32x4){0.f, 0.f, 0.f, 0.f};
    u32x4 ra[4], rb[4];
#pragma unroll
    for (int i = 0; i < 4; ++i) {
        if (CMP) { int t = atok0 + 512 * i; t = t > SEQ - 1 ? SEQ - 1 : t; ra[i] = *(const u32x4*)(ap0 + (size_t)t * lda); }
        else ra[i] = *(const u32x4*)(ap0 + i * astep);
        rb[i] = *(const u32x4*)(bp0 + i * bstep);
    }
    __syncthreads();
#pragma unroll
    for (int i = 0; i < 4; ++i) { *(u32x4*)(As + (lrow + 64 * i) * GP + lc8) = ra[i]; *(u32x4*)(Bs + (lrow + 64 * i) * GP + lc8) = rb[i]; }
    __syncthreads();
    for (int kt = 0; kt < nk; ++kt) {
        const int buf = kt & 1;
        if (kt + 1 < nk) {
#pragma unroll
            for (int i = 0; i < 4; ++i) {
                if (CMP) { int t = atok0 + 512 * i + kt + 1; t = t > SEQ - 1 ? SEQ - 1 : t; ra[i] = *(const u32x4*)(ap0 + (size_t)t * lda); }
                else ra[i] = *(const u32x4*)(ap0 + i * astep + (size_t)(kt + 1) * kstrideA);
                rb[i] = *(const u32x4*)(bp0 + i * bstep + (size_t)(kt + 1) * 64);
            }
        }
        const u16* Ab = As + buf * 256 * GP + (128 * wm + fr) * GP + 8 * fq;
        const u16* Bb = Bs + buf * 256 * GP + (64 * wn + fr) * GP + 8 * fq;
#pragma unroll
        for (int ks = 0; ks < 2; ++ks) {
            bf16x8 bfr[4];
#pragma unroll
            for (int ni = 0; ni < 4; ++ni) bfr[ni] = *(const bf16x8*)(Bb + 16 * ni * GP + 32 * ks);
#pragma unroll
            for (int mi = 0; mi < 8; ++mi) {
                const bf16x8 afr = *(const bf16x8*)(Ab + 16 * mi * GP + 32 * ks);
#pragma unroll
                for (int ni = 0; ni < 4; ++ni) acc[mi][ni] = MFMA16(bfr[ni], afr, acc[mi][ni]);
            }
        }
        if (kt + 1 < nk) {
            u16* Aw = As + (buf ^ 1) * 256 * GP; u16* Bw = Bs + (buf ^ 1) * 256 * GP;
#pragma unroll
            for (int i = 0; i < 4; ++i) { *(u32x4*)(Aw + (lrow + 64 * i) * GP + lc8) = ra[i]; *(u32x4*)(Bw + (lrow + 64 * i) * GP + lc8) = rb[i]; }
        }
        LBAR();
    }
    epi(acc, pm * 256 + 128 * wm, pn * 256 + 64 * wn, lane, lds);
}


namespace pg8 {
#define PG8_LAS __attribute__((address_space(3)))
constexpr int BM = 256, BK = 64, HALF = 128, HTB = HALF * BK * 2, STAGE_BYTES = 8 * HTB;
DI int lds_byte(int r, int c) { const int st = (r >> 4) * 2 + (c >> 5), rr = r & 15, cc = c & 31, ob = rr * 64 + cc * 2; return st * 1024 + (ob ^ (((ob >> 9) & 1) << 5)); }
DI void stage_rc(int b, int& R, int& C) { const int st = b / 1024, sb = b % 1024, swz = sb ^ (((sb >> 9) & 1) << 5); R = (st >> 1) * 16 + swz / 64; C = (st & 1) * 32 + (swz % 64) / 2; }
struct Unit { int pm, pn; };
struct Gemm { const u16* A; const u16* Bt; int K; };

template <class Epi, class Sched, bool ALIGN_EPI>
DI void gemm_phase(PG8_LAS unsigned char* lds, const Gemm g, const Sched& S, Epi& E) {
    const int tid = tid_(), wid = __builtin_amdgcn_readfirstlane(tid >> 6), lane = tid & 63, wr = wid >> 2, wc = wid & 3, fr = lane & 15, fq = lane >> 4;
    const int K = g.K, nt = K / BK;
    unsigned voffA[2];
#pragma unroll
    for (int i = 0; i < 2; ++i) { int R, C; stage_rc(tid * 16 + i * 8192, R, C); voffA[i] = (unsigned)(R * K + C) * 2u; }
    const size_t kstep = (size_t)(BK * 2);
    const size_t hstep = (size_t)HALF * K * 2;
    const size_t tstep = 2 * hstep;
    const unsigned ldsw = (unsigned)wid * 1024u;
    const int aoff = lds_byte(wr * 64 + fr, fq * 8), boff = lds_byte(wc * 32 + fr, fq * 8);
#define PG8_SA(b, h) (((b) * 2 + (h)) * HTB)
#define PG8_SB(b, h) ((4 + (b) * 2 + (h)) * HTB)
#define PG8_STAGE(bufoff, gbase) do { _Pragma("unroll") for (int _i = 0; _i < 2; ++_i) \
        __builtin_amdgcn_global_load_lds((const unsigned*)((const char*)(gbase) + voffA[_i]), (PG8_LAS unsigned*)(lds + (bufoff) + ldsw + _i * 8192), 16, 0, 0); } while (0)
#define PG8_LDA(dst, b, h) do { _Pragma("unroll") for (int m = 0; m < 4; ++m) _Pragma("unroll") for (int k = 0; k < 2; ++k) dst[m][k] = *(const PG8_LAS bf16x8*)(lds + PG8_SA(b, h) + aoff + m * 2048 + k * 1024); } while (0)
#define PG8_LDB(dst, b, h) do { _Pragma("unroll") for (int n = 0; n < 2; ++n) _Pragma("unroll") for (int k = 0; k < 2; ++k) dst[n][k] = *(const PG8_LAS bf16x8*)(lds + PG8_SB(b, h) + boff + n * 2048 + k * 1024); } while (0)
#define PG8_MMA(ai, bj, At, Bt) do { __builtin_amdgcn_s_setprio(1); _Pragma("unroll") for (int m = 0; m < 4; ++m) _Pragma("unroll") for (int n = 0; n < 2; ++n) _Pragma("unroll") for (int k = 0; k < 2; ++k) \
        acc[ai][bj][m][n] = __builtin_amdgcn_mfma_f32_16x16x32_bf16(Bt[n][k], At[m][k], acc[ai][bj][m][n], 0, 0, 0); __builtin_amdgcn_s_setprio(0); } while (0)
#define PG8_WAIT_V(n) asm volatile("s_waitcnt vmcnt(" #n ")" ::: "memory")
#define PG8_WAIT_L(n) asm volatile("s_waitcnt lgkmcnt(" #n ")" ::: "memory")
#define PG8_BAR __builtin_amdgcn_s_barrier()
#define PG8_SCHED __builtin_amdgcn_sched_barrier(0)
    Unit cur, nxt; int ui = 0;
    if (!S.next(0, cur)) return;
    f32x4 acc[2][2][4][2];
#pragma unroll
    for (int a = 0; a < 2; ++a)
#pragma unroll
        for (int b = 0; b < 2; ++b)
#pragma unroll
            for (int m = 0; m < 4; ++m)
#pragma unroll
                for (int n = 0; n < 2; ++n) acc[a][b][m][n] = (f32x4){0.f, 0.f, 0.f, 0.f};
    bf16x8 At[4][2], B0[2][2], B1[2][2];
    const char* cA = (const char*)g.A + (size_t)cur.pm * tstep; const char* cB = (const char*)g.Bt + (size_t)cur.pn * tstep;
    E.pre(cur, wr, fr);
    PG8_STAGE(PG8_SB(0, 0), cB); PG8_STAGE(PG8_SB(0, 1), cB + hstep); PG8_STAGE(PG8_SA(0, 0), cA); PG8_STAGE(PG8_SA(0, 1), cA + hstep);
    if (wr == 1) PG8_BAR;
    PG8_WAIT_V(2); PG8_BAR;
    PG8_STAGE(PG8_SB(1, 0), cB + kstep); PG8_STAGE(PG8_SA(1, 0), cA + kstep); PG8_STAGE(PG8_SB(1, 1), cB + hstep + kstep);
    PG8_WAIT_V(6); PG8_BAR;
    for (;;) {
        const bool has_next = S.next(ui + 1, nxt);
        const char* nA = has_next ? (const char*)g.A + (size_t)nxt.pm * tstep : cA; const char* nB = has_next ? (const char*)g.Bt + (size_t)nxt.pn * tstep : cB;
        for (int t = 0; t < nt; t += 2) {
            const bool last = (t == nt - 2);
            const char* a1 = cA + (size_t)(t + 1) * kstep;
            const char* a2 = last ? nA : cA + (size_t)(t + 2) * kstep; const char* b2 = last ? nB : cB + (size_t)(t + 2) * kstep;
            const char* a3 = a2 + kstep; const char* b3 = b2 + kstep;
            PG8_LDB(B0, 0, 0); PG8_LDB(B1, 0, 1); PG8_SCHED; PG8_LDA(At, 0, 0); PG8_STAGE(PG8_SA(1, 1), a1 + hstep);
            PG8_WAIT_V(8); PG8_WAIT_L(0); PG8_BAR; PG8_MMA(0, 0, At, B0); PG8_MMA(0, 1, At, B1); PG8_BAR; PG8_SCHED;
            PG8_LDA(At, 0, 1); PG8_STAGE(PG8_SB(0, 0), b2); PG8_STAGE(PG8_SB(0, 1), b2 + hstep); PG8_STAGE(PG8_SA(0, 0), a2);
            PG8_WAIT_V(8); PG8_WAIT_L(0); PG8_BAR; PG8_MMA(1, 0, At, B0); PG8_MMA(1, 1, At, B1); PG8_BAR; PG8_SCHED;
            PG8_LDB(B0, 1, 0); PG8_LDB(B1, 1, 1); PG8_SCHED; PG8_LDA(At, 1, 0); PG8_STAGE(PG8_SA(0, 1), a2 + hstep);
            PG8_WAIT_V(8); PG8_WAIT_L(0); PG8_BAR; PG8_MMA(0, 0, At, B0); PG8_MMA(0, 1, At, B1); PG8_BAR; PG8_SCHED;
            PG8_LDA(At, 1, 1); PG8_STAGE(PG8_SB(1, 0), b3); PG8_STAGE(PG8_SB(1, 1), b3 + hstep); PG8_STAGE(PG8_SA(1, 0), a3);
            PG8_WAIT_V(8); PG8_WAIT_L(0); PG8_BAR; PG8_MMA(1, 0, At, B0); PG8_MMA(1, 1, At, B1); PG8_BAR; PG8_SCHED;
        }
        if constexpr (ALIGN_EPI) { if (wr == 0) PG8_BAR; }
        E(acc, cur, wr, wc, fr, fq);
        if (!has_next) break;
#pragma unroll
        for (int a = 0; a < 2; ++a)
#pragma unroll
            for (int b = 0; b < 2; ++b)
#pragma unroll
                for (int m = 0; m < 4; ++m)
#pragma unroll
                    for (int n = 0; n < 2; ++n) acc[a][b][m][n] = (f32x4){0.f, 0.f, 0.f, 0.f};
        cur = nxt; cA = nA; cB = nB; ++ui;
        E.pre(cur, wr, fr);
        if constexpr (ALIGN_EPI) { if (wr == 1) PG8_BAR; }
    }
    PG8_WAIT_V(0);
    if constexpr (!ALIGN_EPI) { if (wr == 0) PG8_BAR; }
    PG8_BAR;
#undef PG8_SA
#undef PG8_SB
#undef PG8_STAGE
#undef PG8_LDA
#undef PG8_LDB
#undef PG8_MMA
#undef PG8_WAIT_V
#undef PG8_WAIT_L
#undef PG8_BAR
#undef PG8_SCHED
}
struct SchedIn { int NT, per, slot, xcd;
    DI bool next(int i, Unit& u) const { const int U = slot + i * per; if (U >= 32 * NT) return false; const int g = U / (8 * NT), r = U - g * 8 * NT; u.pm = xcd * 32 + 8 * g + (r & 7); u.pn = r >> 3; return true; } };
struct SchedOut { int pm;
    DI bool next(int i, Unit& u) const { if (i >= 4) return false; u.pm = pm; u.pn = i; return true; } };
struct SchedOutX { int per, slot, xcd;
    DI bool next(int i, Unit& u) const { const int U = slot + i * per; if (U >= 128) return false; u.pm = xcd * 32 + 8 * (U >> 5) + (U & 7); u.pn = (U & 31) >> 3; return true; } };
struct SchedOne { int pm, pn; bool on;
    DI bool next(int i, Unit& u) const { if (i > 0 || !on) return false; u.pm = pm; u.pn = pn; return true; } };
}


DI void tr_put8(unsigned char* T, int fr, int chunk, int half8, u32x2 w) { *(u32x2*)(T + fr * 128 + ((chunk ^ (fr & 7)) << 4) + half8 * 8) = w; }
DI void tr_put16(unsigned char* T, int fr, int chunk, f32x4 w) { *(f32x4*)(T + fr * 128 + ((chunk ^ (fr & 7)) << 4)) = w; }
DI u32x4 tr_get(const unsigned char* T, int r, int chunk) { return *(const u32x4*)(T + r * 128 + ((chunk ^ (r & 7)) << 4)); }

enum { OP_PLAIN = 0, OP_NORMROPE = 1, OP_NORM = 2, OP_SILU = 3, OP_SIGMOID = 4, OP_LOGF = 5 };

struct EpiZ {
    u16* Z; int ldz; const float* rs; int layer; const Params* p; const float* cs; const float* sn; unsigned char* tr; bool rs4;
    DI void pre(const pg8::Unit&, int, int) {}
    DI void operator()(f32x4 (&acc)[2][2][4][2], const pg8::Unit& u, int wr, int wc, int fr, int fq) {
        asm volatile("" : "+v"(fr), "+v"(fq));
        const int row0 = 256 * u.pm + 64 * wr, col0 = 256 * u.pn + 64 * wc, grp = col0 >> 6;
        int op = OP_PLAIN; const float* gain = nullptr;
        if (layer == 0) {
            if (grp < 8) { op = OP_NORMROPE; gain = p->in[9]; }
            else if (grp < 10) { op = OP_NORMROPE; gain = p->in[10]; }
            else if (grp < 12) op = OP_PLAIN;
            else if (grp < 20) op = OP_SILU;
            else if (grp < 28) op = OP_PLAIN;
            else if (grp < 36) op = OP_SILU;
            else if (grp < 40) { op = OP_NORM; gain = p->in[5]; }
            else op = OP_SILU;
        } else if (layer == 1) {
            if (grp < 8) op = OP_SILU;
            else if (grp < 16) op = OP_LOGF;
            else if (grp < 24) op = OP_PLAIN;
            else if (grp < 32) op = OP_SILU;
            else if (grp < 40) { op = OP_NORMROPE; gain = p->in[23]; }
            else if (grp < 44) op = OP_PLAIN;
            else if (grp < 46) { op = OP_NORMROPE; gain = p->in[25]; }
            else if (grp < 48) op = OP_PLAIN;
            else if (grp < 50) { op = OP_NORMROPE; gain = p->in[26]; }
            else if (grp < 52) op = OP_PLAIN;
            else if (grp < 60) op = OP_SILU;
            else if (grp < 64) { op = OP_NORM; gain = p->in[5] + 64; }
            else if (grp < 68) op = OP_SILU;
            else if (grp < 69) op = OP_SIGMOID;
            else op = OP_PLAIN;
        } else {
            if (grp < 4) { op = OP_NORM; gain = p->in[6] + 64 * (layer - 2); }
            else op = OP_PLAIN;
        }
        f32x4 gn[4];
        if (op == OP_NORMROPE || op == OP_NORM) {
#pragma unroll
            for (int ni = 0; ni < 4; ++ni) gn[ni] = *(const f32x4*)(gain + 16 * ni + 4 * fq);
        } else if (op == OP_LOGF) {
            const float* lbp = p->in[21]; const int ch0 = (grp - 8) * 64;
#pragma unroll
            for (int ni = 0; ni < 4; ++ni) {
                const f32x4 p0 = *(const f32x4*)(lbp + ch0 + 16 * ni + 4 * fq), p1 = *(const f32x4*)(lbp + 512 + ch0 + 16 * ni + 4 * fq);
#pragma unroll
                for (int r = 0; r < 4; ++r) gn[ni][r] = 1.f / (1.f + expf(p0[r] - p1[r]));
            }
        }
        float rsv[8];
#pragma unroll
        for (int mi = 0; mi < 8; ++mi) {
            const float* rp = rs + row0 + 128 * (mi >> 2) + 16 * (mi & 3) + fr;
            rsv[mi] = rs4 ? rsqrtf(((rp[0] + rp[TOK]) + (rp[2 * TOK] + rp[3 * TOK])) * (1.f / 1024.f) + EPS) : rp[0];
        }
        f32x4 invf[2];
        if (op == OP_NORMROPE) {
#pragma unroll
            for (int ni = 0; ni < 2; ++ni)
#pragma unroll
                for (int r = 0; r < 4; ++r) invf[ni][r] = exp2f(-(float)(16 * ni + 4 * fq + r) * (13.287712379549449f / 32.f)) * 0.15915494309189535f;
        }
#pragma unroll
        for (int mi = 0; mi < 8; ++mi) {
            const int row = row0 + 128 * (mi >> 2) + 16 * (mi & 3) + fr;
            const float s = rsv[mi];
            f32x4 v[4];
#pragma unroll
            for (int ni = 0; ni < 4; ++ni) v[ni] = acc[mi >> 2][ni >> 1][mi & 3][ni & 1] * s;
            if (op == OP_NORMROPE || op == OP_NORM) {
                float ss = 0.f;
#pragma unroll
                for (int ni = 0; ni < 4; ++ni) ss += v[ni][0] * v[ni][0] + v[ni][1] * v[ni][1] + v[ni][2] * v[ni][2] + v[ni][3] * v[ni][3];
                ss = xor32_sum(xor16_sum(ss));
                const float inv = rsqrtf(ss * (1.f / 64.f) + EPS);
#pragma unroll
                for (int ni = 0; ni < 4; ++ni) v[ni] = v[ni] * inv * gn[ni];
                if (op == OP_NORMROPE) {
#pragma unroll
                    for (int ni = 0; ni < 2; ++ni) {
                        const float tf = (float)(row & (SEQ - 1));
                        f32x4 c, sv;
#pragma unroll
                        for (int r = 0; r < 4; ++r) { const float fx = __builtin_amdgcn_fractf(tf * invf[ni][r]); c[r] = __builtin_amdgcn_cosf(fx); sv[r] = __builtin_amdgcn_sinf(fx); }
                        const f32x4 x1 = v[ni], x2 = v[ni + 2];
                        v[ni] = x1 * c - x2 * sv; v[ni + 2] = x2 * c + x1 * sv;
                    }
                }
            } else if (op == OP_SILU) {
#pragma unroll
                for (int ni = 0; ni < 4; ++ni)
#pragma unroll
                    for (int r = 0; r < 4; ++r) v[ni][r] = siluf_(v[ni][r]);
            } else if (op == OP_SIGMOID) {
#pragma unroll
                for (int ni = 0; ni < 4; ++ni)
#pragma unroll
                    for (int r = 0; r < 4; ++r) v[ni][r] = sigmoidf_(v[ni][r]);
            } else if (op == OP_LOGF) {
#pragma unroll
                for (int ni = 0; ni < 4; ++ni)
#pragma unroll
                    for (int r = 0; r < 4; ++r) { const float lb = gn[ni][r]; v[ni][r] = __logf(lb + (1.f - lb) * sigmoidf_(v[ni][r])); }
            }
#pragma unroll
            for (int ni = 0; ni < 4; ++ni) { u32x2 w; w.x = pack2(v[ni][0], v[ni][1]); w.y = pack2(v[ni][2], v[ni][3]); tr_put8(tr, fr, 2 * ni + (fq >> 1), fq & 1, w); }
            {
                const int lane = fr + 16 * fq, c8 = lane & 7;
                const int rb = row0 + 128 * (mi >> 2) + 16 * (mi & 3);
#pragma unroll
                for (int k = 0; k < 2; ++k) { const int r = (lane >> 3) + 8 * k; __builtin_nontemporal_store(tr_get(tr, r, c8), (u32x4*)(Z + (size_t)(rb + r) * ldz + col0 + 8 * c8)); }
            }
            CFENCE;
        }
    }
};

struct EpiOut0 {
    const float* x; float* out; u16* xb; float* red; unsigned char* tr; float* rsp;
    int par, ppm, ppn;
    DI void pre(const pg8::Unit&, int, int) {}
    DI void flush(int wr, int wc, int fr, int fq) {
        if (ppm >= 0 && wc == 0 && fq == 0) {
            const float* rd = red + (par ^ 1) * 1024;
#pragma unroll
            for (int mi = 0; mi < 8; ++mi) {
                const int r = 64 * wr + 128 * (mi >> 2) + 16 * (mi & 3) + fr;
                rsp[(size_t)ppn * TOK + 256 * ppm + r] = (rd[r] + rd[256 + r]) + (rd[512 + r] + rd[768 + r]);
            }
        }
    }
    DI void operator()(f32x4 (&acc)[2][2][4][2], const pg8::Unit& u, int wr, int wc, int fr, int fq) {
        asm volatile("" : "+v"(fr), "+v"(fq));
        const int row0 = 256 * u.pm + 64 * wr, col0 = 256 * u.pn + 64 * wc;
        const int lane = fr + 16 * fq, c8 = lane & 7, lr = lane >> 3;
        f32x4 xr[2][2];
#pragma unroll
        for (int k = 0; k < 2; ++k) xr[0][k] = __builtin_nontemporal_load((const f32x4*)(x + (size_t)(row0 + lr + 8 * k) * DM + col0 + 4 * c8));
        flush(wr, wc, fr, fq);
        float* rw = red + par * 1024 + wc * 256 + 64 * wr;
        float ss = 0.f; u32x2 wq[2][2];
#pragma unroll
        for (int st = 0; st < 16; ++st) {
            const int mi = st >> 1, hh = st & 1;
            const int rl = 128 * (mi >> 2) + 16 * (mi & 3) + fr;
            if (st < 15) {
                const int mn = (st + 1) >> 1, hn = (st + 1) & 1;
                const int rbn = row0 + 128 * (mn >> 2) + 16 * (mn & 3);
#pragma unroll
                for (int k = 0; k < 2; ++k) xr[(st + 1) & 1][k] = __builtin_nontemporal_load((const f32x4*)(x + (size_t)(rbn + lr + 8 * k) * DM + col0 + 32 * hn + 4 * c8));
            }
#pragma unroll
            for (int k = 0; k < 2; ++k) tr_put16(tr, lr + 8 * k, c8, xr[st & 1][k]);
#pragma unroll
            for (int n = 0; n < 2; ++n) {
                const f32x4 xv = *(const f32x4*)(tr + fr * 128 + (((4 * n + fq) ^ (fr & 7)) << 4));
                const f32x4 v = acc[mi >> 2][hh][mi & 3][n] + xv;
                wq[hh][n].x = pack2(v[0], v[1]); wq[hh][n].y = pack2(v[2], v[3]);
                ss += v[0] * v[0] + v[1] * v[1] + v[2] * v[2] + v[3] * v[3];
            }
            if (hh) {
                ss = xor32_sum(xor16_sum(ss));
                if (fq == 0) rw[rl] = ss;
                ss = 0.f;
#pragma unroll
                for (int h2 = 0; h2 < 2; ++h2)
#pragma unroll
                    for (int n = 0; n < 2; ++n) tr_put8(tr, fr, 2 * (2 * h2 + n) + (fq >> 1), fq & 1, wq[h2][n]);
                const int rb = row0 + 128 * (mi >> 2) + 16 * (mi & 3);
#pragma unroll
                for (int k = 0; k < 2; ++k) { const int r = lr + 8 * k; *(u32x4*)(xb + (size_t)(rb + r) * DM + col0 + 8 * c8) = tr_get(tr, r, c8); }
            }
            CFENCE;
        }
        ppm = u.pm; ppn = u.pn; par ^= 1;
    }
};
struct EpiOut1 {
    float* out; const u16* xb; unsigned char* tr;
    DI void pre(const pg8::Unit&, int, int) {}
    DI void operator()(f32x4 (&acc)[2][2][4][2], const pg8::Unit& u, int wr, int wc, int fr, int fq) const {
        asm volatile("" : "+v"(fr), "+v"(fq));
        const int row0 = 256 * u.pm + 64 * wr, col0 = 256 * u.pn + 64 * wc;
        const int lane = fr + 16 * fq, c8 = lane & 7, lr = lane >> 3;
        u32x4 hb[2][2];
#pragma unroll
        for (int k = 0; k < 2; ++k) hb[0][k] = *(const u32x4*)(xb + (size_t)(row0 + lr + 8 * k) * DM + col0 + 8 * c8);
#pragma unroll
        for (int mi = 0; mi < 8; ++mi) {
            const int rb = row0 + 128 * (mi >> 2) + 16 * (mi & 3);
            if (mi < 7) {
                const int rbn = row0 + 128 * ((mi + 1) >> 2) + 16 * ((mi + 1) & 3);
#pragma unroll
                for (int k = 0; k < 2; ++k) hb[(mi + 1) & 1][k] = *(const u32x4*)(xb + (size_t)(rbn + lr + 8 * k) * DM + col0 + 8 * c8);
            }
#pragma unroll
            for (int k = 0; k < 2; ++k) { const int r = lr + 8 * k; *(u32x4*)(tr + r * 128 + ((c8 ^ (r & 7)) << 4)) = hb[mi & 1][k]; }
            u32x2 hw[4];
#pragma unroll
            for (int ni = 0; ni < 4; ++ni) hw[ni] = *(const u32x2*)(tr + fr * 128 + (((2 * ni + (fq >> 1)) ^ (fr & 7)) << 4) + 8 * (fq & 1));
#pragma unroll
            for (int hh = 0; hh < 2; ++hh) {
#pragma unroll
                for (int n = 0; n < 2; ++n) {
                    const u32x2 w = hw[2 * hh + n];
                    const f32x4 a = acc[mi >> 2][hh][mi & 3][n];
                    tr_put16(tr, fr, 4 * n + fq, (f32x4){bflo(w.x) + a[0], bfhi(w.x) + a[1], bflo(w.y) + a[2], bfhi(w.y) + a[3]});
                }
#pragma unroll
                for (int k = 0; k < 2; ++k) { const int r = lr + 8 * k; __builtin_nontemporal_store(tr_get(tr, r, c8), (u32x4*)(out + (size_t)(rb + r) * DM + col0 + 32 * hh + 4 * c8)); }
            }
            CFENCE;
        }
    }
};

struct EpiCmp {
    const float* bias; const float* w2; const float* gain; u16* dst; bool isk; const float* cs; const float* sn;
    DI void operator()(f32x4 (&acc)[8][4], int row0, int col0, int lane, unsigned char* lds) const {
        const int fr = lane & 15, fq = lane >> 4, tid = tid_();
        float* Hs = (float*)lds;
        if (col0 < 128) {
            const int lrow0 = row0 & 255;
#pragma unroll
            for (int mi = 0; mi < 8; ++mi)
#pragma unroll
                for (int ni = 0; ni < 4; ++ni)
#pragma unroll
                    for (int r = 0; r < 4; ++r) { const int c = col0 + 16 * ni + 4 * fq + r; Hs[(lrow0 + 16 * mi + fr) * 129 + c] = siluf_(acc[mi][ni][r] + bias[c]); }
        }
        __syncthreads();
        const int lrow = tid >> 1, half = tid & 1;
        const int row = (row0 & ~255) + lrow;
        float o[32];
#pragma unroll
        for (int c = 0; c < 32; ++c) o[c] = 0.f;
        for (int j = 0; j < 128; ++j) {
            const float hv = Hs[lrow * 129 + j];
            const float* wr = w2 + j * 64 + 32 * half;
#pragma unroll
            for (int c4 = 0; c4 < 8; ++c4) { const f32x4 w = *(const f32x4*)(wr + 4 * c4); o[4 * c4] += hv * w[0]; o[4 * c4 + 1] += hv * w[1]; o[4 * c4 + 2] += hv * w[2]; o[4 * c4 + 3] += hv * w[3]; }
        }
        if (isk) {
            float ss = 0.f;
#pragma unroll
            for (int c = 0; c < 32; ++c) ss += o[c] * o[c];
            ss += __shfl_xor(ss, 1);
            const float inv = rsqrtf(ss * (1.f / 64.f) + EPS);
            const int n = (row >> 1) & 127; int t = 16 * n + 31; t = t > SEQ - 1 ? SEQ - 1 : t;
#pragma unroll
            for (int c = 0; c < 32; ++c) {
                const float mine = o[c] * inv * gain[32 * half + c];
                const float other = __shfl_xor(mine, 1);
                const float cv = cs[t * 32 + c], sv = sn[t * 32 + c];
                o[c] = half == 0 ? (mine * cv - other * sv) : (mine * cv + other * sv);
            }
        }
        u16* dp = dst + (size_t)row * 64 + 32 * half;
#pragma unroll
        for (int c8 = 0; c8 < 4; ++c8) { u32x4 w; w.x = pack2(o[8 * c8], o[8 * c8 + 1]); w.y = pack2(o[8 * c8 + 2], o[8 * c8 + 3]); w.z = pack2(o[8 * c8 + 4], o[8 * c8 + 5]); w.w = pack2(o[8 * c8 + 6], o[8 * c8 + 7]); *(u32x4*)(dp + 8 * c8) = w; }
        __syncthreads();
    }
};

DI int srccol(int mode, int n) {
    if (mode == 0) return n;
    if (mode == 1) { if (n < 3328) return n; if (n < 4352) return n + 24; if (n < 4376) return n - 1024; return -1; }
    return n < 128 ? n : -1;
}
DI int physrow(int n) { const int w = n & 255; return (n & ~255) + 128 * ((w >> 5) & 1) + 32 * (w >> 6) + (w & 31); }
DI void tconv(unsigned char* lds, const float* src, int ldsrc, int K, int N, u16* dst, const float* gain, int mode, int first, int stride) {
    float* tl = (float*)lds;
    const int tid = tid_(), nkt = K / 64, ntile = nkt * (N / 64);
    for (int tile = first; tile < ntile; tile += stride) {
        const int k0 = (tile % nkt) * 64, n0 = (tile / nkt) * 64;
#pragma unroll
        for (int i = 0; i < 8; ++i) {
            const int k = (tid >> 6) + 8 * i, n = tid & 63; const int sc = srccol(mode, n0 + n);
            float v = 0.f; if (sc >= 0) { v = src[(size_t)(k0 + k) * ldsrc + sc]; if (gain) v *= gain[k0 + k]; }
            tl[k * 65 + n] = v;
        }
        __syncthreads();
#pragma unroll
        for (int i = 0; i < 8; ++i) { const int n = (tid >> 6) + 8 * i, k = tid & 63; const int pr = mode == 2 ? n0 + n : physrow(n0 + n); dst[(size_t)pr * K + k0 + k] = f2bf(tl[k * 65 + n]); }
        __syncthreads();
    }
}
DI void phase_prep(const Params& p, unsigned char* lds) {
    unsigned char* ws = p.ws;
    const int tid = tid_(), wid = tid >> 6, lane = tid & 63;
    if (blockIdx.x == 0 && tid < 256) ((unsigned*)(ws + OFF_CTR))[tid] = 0u;
    for (int rb = blockIdx.x; rb < (TOK + 8192) / 16; rb += gridDim.x) {
        f32x4 v[2][4]; const float* src[2]; u16* dst[2]; float* rsd[2];
#pragma unroll
        for (int h = 0; h < 2; ++h) {
            const int r = rb * 16 + 2 * wid + h;
            if (r < TOK) { src[h] = p.in[0] + (size_t)r * DM; dst[h] = (u16*)(ws + OFF_XB) + (size_t)r * DM; rsd[h] = (float*)(ws + OFF_RS0) + r; }
            else { const int rr = r - TOK; src[h] = p.in[1] + (size_t)rr * DM; dst[h] = (u16*)(ws + OFF_MEMB) + (size_t)rr * DM; rsd[h] = (float*)(ws + OFF_RSM) + rr; }
#pragma unroll
            for (int i = 0; i < 4; ++i) v[h][i] = __builtin_nontemporal_load((const f32x4*)(src[h] + 4 * (lane + 64 * i)));
        }
#pragma unroll
        for (int h = 0; h < 2; ++h) {
            float ss = 0.f;
#pragma unroll
            for (int i = 0; i < 4; ++i) ss += v[h][i][0] * v[h][i][0] + v[h][i][1] * v[h][i][1] + v[h][i][2] * v[h][i][2] + v[h][i][3] * v[h][i][3];
#pragma unroll
            for (int o = 1; o < 64; o <<= 1) ss += __shfl_xor(ss, o);
            if (lane == 0) *rsd[h] = rsqrtf(ss * (1.f / 1024.f) + EPS);
#pragma unroll
            for (int i = 0; i < 4; ++i) { u32x2 w; w.x = pack2(v[h][i][0], v[h][i][1]); w.y = pack2(v[h][i][2], v[h][i][3]); *(u32x2*)(dst[h] + 4 * (lane + 64 * i)) = w; }
        }
    }
    const int b0 = blockIdx.x, gs = gridDim.x;
    tconv(lds, p.in[7], 2816, 1024, 2816, (u16*)(ws + OFF_WT0), p.in[2], 0, b0, gs);
    tconv(lds, p.in[8], 1024, 1280, 1024, (u16*)(ws + OFF_WO0), nullptr, 0, b0, gs);
    tconv(lds, p.in[4], 512, 1024, 512, (u16*)(ws + OFF_WM), p.in[3], 0, b0, gs);
    tconv(lds, p.in[4] + (size_t)1024 * 512, 512, 1024, 512, (u16*)(ws + OFF_WM) + (size_t)512 * 1024, p.in[3] + 1024, 0, b0, gs);
    for (int idx = blockIdx.x * NTHR + tid; idx < 2048 * 32; idx += gridDim.x * NTHR) {
        const int t = idx >> 5, i = idx & 31;
        const float inv = exp2f(-(float)i * (13.287712379549449f / 32.f));
        const double rev = (double)t * (double)inv * 0.15915494309189535;
        const float fr = (float)(rev - floor(rev));
        ((float*)(ws + OFF_COS))[idx] = __builtin_amdgcn_cosf(fr);
        ((float*)(ws + OFF_SIN))[idx] = __builtin_amdgcn_sinf(fr);
    }
}
DI void prep_layer1(const Params& p, unsigned char* lds, int first, int stride) {
    unsigned char* ws = p.ws;
    const int tid = tid_(), wid = tid >> 6, lane = tid & 63;
    __syncthreads();
    tconv(lds, p.in[19], 4376, 1024, 4608, (u16*)(ws + OFF_WT1), p.in[2] + 1024, 1, first, stride);
    tconv(lds, p.in[20], 1024, 1280, 1024, (u16*)(ws + OFF_WO1), nullptr, 0, first, stride);
    tconv(lds, p.in[29], 128, 2048, 256, (u16*)(ws + OFF_W1K), nullptr, 2, first, stride);
    tconv(lds, p.in[31], 128, 2048, 256, (u16*)(ws + OFF_W1V), nullptr, 2, first, stride);
    for (int task = first; task < 32; task += stride) {
        const int kv = task >> 4, j = (task & 15) * 8 + wid;
        const float* pe = kv ? p.in[28] : p.in[27]; const float* w1 = kv ? p.in[31] : p.in[29];
        float s = 0.f;
        for (int i = lane; i < 2048; i += 64) s += pe[i] * w1[(size_t)i * 128 + j];
#pragma unroll
        for (int o = 1; o < 64; o <<= 1) s += __shfl_xor(s, o);
        if (lane == 0) ((float*)(ws + OFF_BIAS))[kv * 128 + j] = s;
    }
}

struct TileSrc { const u16* k; const u16* v; int kstride, vstride; };
DI void tile_load(const TileSrc& s, u32x4& rk, u32x4& rv, int tid) {
    rk = *(const u32x4*)(s.k + (size_t)(tid >> 3) * s.kstride + (tid & 7) * 8);
    rv = *(const u32x4*)(s.v + (size_t)(tid >> 3) * s.vstride + (tid & 7) * 8);
}
DI void tile_store(u16* Kt, u16* Vt, const u32x4& rk, const u32x4& rv, int tid) {
    *(u32x4*)(Kt + (tid >> 3) * GP + (tid & 7) * 8) = rk;
    *(u32x4*)(Vt + (tid >> 3) * GP + (tid & 7) * 8) = rv;
}
typedef __attribute__((address_space(3))) s16x4 lds_s16x4;
DI s16x4 tr_read(const u16* p) { return __builtin_amdgcn_ds_read_tr16_b64_v4i16((lds_s16x4*)p); }
struct AttnAcc { f32x16 o[2]; float m, l; };
DI void attn_reset(AttnAcc& a) {
#pragma unroll
    for (int i = 0; i < 16; ++i) { a.o[0][i] = 0.f; a.o[1][i] = 0.f; }
    a.m = -1e30f; a.l = 0.f;
}
template <int MODE, class MaskF>
DI void attn_compute(const u16* Kt, const u16* Vt, const bf16x8 (&q)[4], AttnAcc& st, int lane, bool rowon, MaskF valid) {
    const int r32 = lane & 31, h = lane >> 5;
    f32x16 X[2];
#pragma unroll
    for (int kt2 = 0; kt2 < 2; ++kt2) {
#pragma unroll
        for (int i = 0; i < 16; ++i) X[kt2][i] = 0.f;
#pragma unroll
        for (int s = 0; s < 4; ++s) { const bf16x8 kf = *(const bf16x8*)(Kt + (32 * kt2 + r32) * GP + 16 * s + 8 * h); X[kt2] = MFMA32(kf, q[s], X[kt2]); }
    }
    float mx = -1e30f;
    if (MODE == 0) {
#pragma unroll
        for (int kt2 = 0; kt2 < 2; ++kt2)
#pragma unroll
            for (int reg = 0; reg < 16; ++reg) {
                const int kl = 32 * kt2 + (reg & 3) + 8 * (reg >> 2) + 4 * h;
                float t = X[kt2][reg]; t = valid(kl) ? t : -1e30f; X[kt2][reg] = t; mx = fmaxf(mx, t);
            }
    } else {
#pragma unroll
        for (int kt2 = 0; kt2 < 2; ++kt2)
#pragma unroll
            for (int reg = 0; reg < 16; ++reg) mx = fmaxf(mx, X[kt2][reg]);
        if (MODE == 2) mx = rowon ? mx : -1e30f;
    }
    mx = xor32_max(mx);
    const float mn = fmaxf(st.m, mx > -1e29f ? mx * SC_LOG2 : -1e30f);
    const float alpha = ex2(st.m - mn);
    float rsum = 0.f;
#pragma unroll
    for (int kt2 = 0; kt2 < 2; ++kt2)
#pragma unroll
        for (int reg = 0; reg < 16; ++reg) {
            const float t = X[kt2][reg]; float pv = ex2(fmaf(t, SC_LOG2, -mn));
            if (MODE == 0) pv = t > -1e29f ? pv : 0.f;
            if (MODE == 2) pv = rowon ? pv : 0.f;
            X[kt2][reg] = pv; rsum += pv;
        }
    rsum = xor32_sum(rsum);
    st.l = st.l * alpha + rsum; st.m = mn;
#pragma unroll
    for (int i = 0; i < 16; ++i) { st.o[0][i] *= alpha; st.o[1][i] *= alpha; }
    bf16x8 pf[2][2];
#pragma unroll
    for (int kt2 = 0; kt2 < 2; ++kt2)
#pragma unroll
        for (int s = 0; s < 2; ++s) {
            u32x4 w; w.x = pack2(X[kt2][8 * s], X[kt2][8 * s + 1]); w.y = pack2(X[kt2][8 * s + 2], X[kt2][8 * s + 3]);
            w.z = pack2(X[kt2][8 * s + 4], X[kt2][8 * s + 5]); w.w = pack2(X[kt2][8 * s + 6], X[kt2][8 * s + 7]);
            pf[kt2][s] = __builtin_bit_cast(bf16x8, w);
        }
#pragma unroll
    for (int nt = 0; nt < 2; ++nt)
#pragma unroll
        for (int kt2 = 0; kt2 < 2; ++kt2)
#pragma unroll
            for (int s = 0; s < 2; ++s) {
                const u16* vp = Vt + (32 * kt2 + 16 * s + 4 * h + ((lane & 15) >> 2)) * GP + 32 * nt + 16 * ((lane >> 4) & 1) + 4 * (lane & 3);
                const s16x4 lo = tr_read(vp), hi = tr_read(vp + 8 * GP);
                const bf16x8 vf = __builtin_shufflevector(lo, hi, 0, 1, 2, 3, 4, 5, 6, 7);
                st.o[nt] = MFMA32(vf, pf[kt2][s], st.o[nt]);
            }
}
constexpr int LDS_WT = 98304;
DI unsigned char* wtile(unsigned char* lds, int wid) { return lds + LDS_WT + 4096 * wid; }
template <class RowF> DI void rows_to_tile(unsigned char* T, int lane, RowF rowptr) {
#pragma unroll
    for (int k = 0; k < 4; ++k) { const int rr = (lane >> 3) + 8 * k, c = lane & 7; const u32x4 v = *(const u32x4*)(rowptr(rr) + 8 * c); *(u32x4*)(T + rr * 128 + ((c ^ (rr & 7)) << 4)) = v; }
}
template <class RowF> DI void tile_to_rows(const unsigned char* T, int lane, RowF rowptr) {
#pragma unroll
    for (int k = 0; k < 4; ++k) { const int rr = (lane >> 3) + 8 * k, c = lane & 7; *(u32x4*)(rowptr(rr) + 8 * c) = *(const u32x4*)(T + rr * 128 + ((c ^ (rr & 7)) << 4)); }
}
template <class RowF, class GateF> DI void load_q(unsigned char* T, bf16x8 (&q)[4], int lane, RowF qrow, GateF gaterow) {
    u32x4 qv[4], gv[4];
#pragma unroll
    for (int k = 0; k < 4; ++k) { const int rr = (lane >> 3) + 8 * k, c = lane & 7; qv[k] = *(const u32x4*)(qrow(rr) + 8 * c); }
#pragma unroll
    for (int k = 0; k < 4; ++k) { const int rr = (lane >> 3) + 8 * k, c = lane & 7; gv[k] = *(const u32x4*)(gaterow(rr) + 8 * c); }
#pragma unroll
    for (int k = 0; k < 4; ++k) { const int rr = (lane >> 3) + 8 * k, c = lane & 7; *(u32x4*)(T + rr * 128 + ((c ^ (rr & 7)) << 4)) = qv[k]; }
    const int r32 = lane & 31, h = lane >> 5;
#pragma unroll
    for (int s = 0; s < 4; ++s) q[s] = *(const bf16x8*)(T + r32 * 128 + (((2 * s + h) ^ (r32 & 7)) << 4));
#pragma unroll
    for (int k = 0; k < 4; ++k) { const int rr = (lane >> 3) + 8 * k, c = lane & 7; *(u32x4*)(T + rr * 128 + ((c ^ (rr & 7)) << 4)) = gv[k]; }
}
template <class DstF> DI void store_gated(unsigned char* T, const f32x16 (&o)[2], float mul, int lane, DstF dstrow) {
    const int r32 = lane & 31, h = lane >> 5;
#pragma unroll
    for (int nt = 0; nt < 2; ++nt)
#pragma unroll
        for (int qd = 0; qd < 4; ++qd) {
            unsigned char* a = T + r32 * 128 + (((4 * nt + qd) ^ (r32 & 7)) << 4) + 8 * h;
            const u32x2 g = *(const u32x2*)a;
            u32x2 w; w.x = pack2(o[nt][4 * qd] * mul * bflo(g.x), o[nt][4 * qd + 1] * mul * bfhi(g.x)); w.y = pack2(o[nt][4 * qd + 2] * mul * bflo(g.y), o[nt][4 * qd + 3] * mul * bfhi(g.y));
            *(u32x2*)a = w;
        }
    tile_to_rows(T, lane, dstrow);
}

template <class SrcF, class CompF>
DI void tile_loop(unsigned char* lds, int n, int tid, SrcF src, CompF comp) {
    u16* K0 = (u16*)lds; u16* V0 = K0 + 64 * GP; u16* K1 = (u16*)(lds + 18432); u16* V1 = K1 + 64 * GP;
    u32x4 rk[2], rv[2];
    { const TileSrc s0 = src(0); tile_load(s0, rk[0], rv[0], tid); }
    { const TileSrc s1 = src(n > 1 ? 1 : 0); tile_load(s1, rk[1], rv[1], tid); }
    LBAR();
    tile_store(K0, V0, rk[0], rv[0], tid);
    LBAR();
    for (int i2 = 0; i2 < n; i2 += 2) {
#pragma unroll
        for (int j = 0; j < 2; ++j) {
            const int i = i2 + j;
            { const int nx = i + 2 < n ? i + 2 : n - 1; const TileSrc s2 = src(nx); tile_load(s2, rk[j], rv[j], tid); }
            __builtin_amdgcn_sched_barrier(0);
            if (i < n) comp(i, j ? K1 : K0, j ? V1 : V0);
            __builtin_amdgcn_sched_barrier(0);
            tile_store(j ? K0 : K1, j ? V0 : V1, rk[j ^ 1], rv[j ^ 1], tid);
            LBAR();
        }
    }
}

DI void item_swa(const Params& p, unsigned char* lds, int item) {
    const u16* Z = (const u16*)(p.ws + OFF_Z); u16* MIX = (u16*)(p.ws + OFF_MIX);
    const int tid = tid_(), wid = tid >> 6, lane = tid & 63, r32 = lane & 31;
    const int qt = item & 31, kvh = (item >> 5) & 1, b = item >> 6;
    const int tok = 64 * qt + 8 * wid + (r32 >> 2), head = 4 * kvh + (r32 & 3);
    const size_t row = (size_t)b * SEQ + tok;
    unsigned char* WT = wtile(lds, wid);
    const size_t rowb = (size_t)b * SEQ + 64 * qt + 8 * wid;
    bf16x8 q[4]; load_q(WT, q, lane, [&](int rr) { return Z + (rowb + (rr >> 2)) * LDZ0 + 64 * (4 * kvh + (rr & 3)); },
                        [&](int rr) { return Z + (rowb + (rr >> 2)) * LDZ0 + 768 + 64 * (4 * kvh + (rr & 3)); });
    AttnAcc st; attn_reset(st);
    const int kt0 = qt >= 2 ? qt - 2 : 0;
    tile_loop(lds, qt - kt0 + 1, tid,
        [&](int i) { const u16* zb = Z + ((size_t)b * SEQ + 64 * (kt0 + i)) * LDZ0; return TileSrc{zb + 512 + 64 * kvh, zb + 640 + 64 * kvh, LDZ0, LDZ0}; },
        [&](int i, const u16* Kt, const u16* Vt) {
            const int kt = kt0 + i, base = 64 * kt;
            if (kt == qt - 1) attn_compute<1>(Kt, Vt, q, st, lane, true, [&](int) { return true; });
            else attn_compute<0>(Kt, Vt, q, st, lane, true, [&](int kl) { const int s = base + kl; return s <= tok && s > tok - 128; });
        });
    const float sink = p.in[11][head];
    const float denom = st.l + ex2(sink * LOG2E - st.m);
    store_gated(WT, st.o, 1.f / denom, lane, [&](int rr) { return MIX + (rowb + (rr >> 2)) * LDMIX + 64 * (4 * kvh + (rr & 3)); });
}

DI void item_mem(const Params& p, unsigned char* lds, int item, int layer) {
    const u16* Z = (const u16*)(p.ws + OFF_Z); u16* MIX = (u16*)(p.ws + OFF_MIX);
    const u16* MKV = (const u16*)(p.ws + OFF_MKV) + (size_t)layer * 8192 * 512;
    const int ldz = layer ? LDZ1 : LDZ0, qcol = layer ? 3840 : 2304, gcol = layer ? 4096 : 2560;
    const int tid = tid_(), wid = tid >> 6, lane = tid & 63, r32 = lane & 31;
    const int tile = item & 7, head = (item >> 3) & 3, b = item >> 5;
    const int tok = 256 * tile + 32 * wid + r32;
    const size_t row = (size_t)b * SEQ + tok;
    unsigned char* WT = wtile(lds, wid);
    const size_t rowb = (size_t)b * SEQ + 256 * tile + 32 * wid;
    const u16* kb = MKV + (size_t)(b * 256) * 512 + 64 * head;
    u32x4 rk[4], rv[4];
#pragma unroll
    for (int t = 0; t < 4; ++t) { const TileSrc ts{kb + (size_t)(64 * t) * 512, kb + (size_t)(64 * t) * 512 + 256, 512, 512}; tile_load(ts, rk[t], rv[t], tid); }
    bf16x8 q[4]; load_q(WT, q, lane, [&](int rr) { return Z + (rowb + rr) * ldz + qcol + 64 * head; }, [&](int rr) { return Z + (rowb + rr) * ldz + gcol + 64 * head; });
    AttnAcc st; attn_reset(st);
    LBAR();
#pragma unroll
    for (int t = 0; t < 4; ++t) tile_store((u16*)(lds + 18432 * t), (u16*)(lds + 18432 * t) + 64 * GP, rk[t], rv[t], tid);
    LBAR();
#pragma unroll 1
    for (int t = 0; t < 4; ++t) { const u16* kt = (const u16*)(lds + 18432 * t); attn_compute<1>(kt, kt + 64 * GP, q, st, lane, true, [&](int) { return true; }); }
    store_gated(WT, st.o, 1.f / st.l, lane, [&](int rr) { return MIX + (rowb + rr) * LDMIX + 1024 + 64 * head; });
}

DI void item_nsa(const Params& p, unsigned char* lds, int item) {
    const u16* Z = (const u16*)(p.ws + OFF_Z); u16* MIX = (u16*)(p.ws + OFF_MIX);
    const u16* KC = (const u16*)(p.ws + OFF_KC); const u16* VC = (const u16*)(p.ws + OFF_VC);
    u16* Kc = (u16*)(lds + 36864); u16* Vtc = (u16*)(lds + 55296);
    float* pc4 = (float*)(lds + 73728); float* pl = (float*)(lds + 82432);
    unsigned* selm = (unsigned*)(lds + 91136); unsigned* umw = (unsigned*)(lds + 91392);
    const int tid = tid_(), wid = tid >> 6, lane = tid & 63, r32 = lane & 31, h = lane >> 5;
    const int qt = 31 - (item >> 6), kvh = item & 1, b = (item >> 1) & 31;
    const int ttl = 8 * wid + (r32 >> 2);
    const int tok = 64 * qt + ttl, head = 4 * kvh + (r32 & 3);
    const size_t row = (size_t)b * SEQ + tok;
    const u16* zrow = Z + row * LDZ1;
    unsigned char* WT = wtile(lds, wid);
    const size_t rowb = (size_t)b * SEQ + 64 * qt + 8 * wid;
    bf16x8 q[4]; load_q(WT, q, lane, [&](int rr) { return Z + (rowb + (rr >> 2)) * LDZ1 + 2048 + 64 * (4 * kvh + (rr & 3)); },
                        [&](int rr) { return Z + (rowb + (rr >> 2)) * LDZ1 + 3328 + 64 * (4 * kvh + (rr & 3)); });
    float gcmp, gsel, gwin;
    { const u16* gp = zrow + 4352 + 3 * head; gcmp = bf2f(gp[0]); gsel = bf2f(gp[1]); gwin = bf2f(gp[2]); }
    f32x16 osum[2];
    {
        const u16* kcb = KC + ((size_t)(b * 128) * 2 + kvh) * 64; const u16* vcb = VC + ((size_t)(b * 128) * 2 + kvh) * 64;
        u32x4 ck[2], cv[2];
#pragma unroll
        for (int i = 0; i < 2; ++i) {
            ck[i] = *(const u32x4*)(kcb + (size_t)((tid >> 3) + 64 * i) * 128 + (tid & 7) * 8);
            cv[i] = *(const u32x4*)(vcb + (size_t)((tid >> 3) + 64 * i) * 128 + (tid & 7) * 8);
        }
        __syncthreads();
#pragma unroll
        for (int i = 0; i < 2; ++i) {
            const int key = (tid >> 3) + 64 * i;
            *(u32x4*)(Kc + key * GP + (tid & 7) * 8) = ck[i];
            *(u32x4*)(Vtc + key * GP + (tid & 7) * 8) = cv[i];
        }
    }
    __syncthreads();
    {
        f32x16 X[4];
#pragma unroll
        for (int k4 = 0; k4 < 4; ++k4) {
#pragma unroll
            for (int i = 0; i < 16; ++i) X[k4][i] = 0.f;
#pragma unroll
            for (int s = 0; s < 4; ++s) { const bf16x8 kf = *(const bf16x8*)(Kc + (32 * k4 + r32) * GP + 16 * s + 8 * h); X[k4] = MFMA32(kf, q[s], X[k4]); }
        }
        const int nmax = tok >= 31 ? ((tok - 31) >> 4) : -1;
        float mx = -1e30f;
#pragma unroll
        for (int k4 = 0; k4 < 4; ++k4)
#pragma unroll
            for (int reg = 0; reg < 16; ++reg) { const int n = 32 * k4 + (reg & 3) + 8 * (reg >> 2) + 4 * h; float t = X[k4][reg] * SC_LOG2; t = n <= nmax ? t : -1e30f; X[k4][reg] = t; mx = fmaxf(mx, t); }
        mx = xor32_max(mx);
        float rsum = 0.f;
#pragma unroll
        for (int k4 = 0; k4 < 4; ++k4)
#pragma unroll
            for (int reg = 0; reg < 16; ++reg) { const float t = X[k4][reg]; const float pv = t > -1e29f ? ex2(t - mx) : 0.f; X[k4][reg] = pv; rsum += pv; }
        rsum = xor32_sum(rsum);
        const float inv = rsum > 0.f ? 1.f / rsum : 0.f;
#pragma unroll
        for (int k4 = 0; k4 < 4; ++k4)
#pragma unroll
            for (int reg = 0; reg < 16; ++reg) X[k4][reg] *= inv;
#pragma unroll
        for (int k4 = 0; k4 < 4; ++k4)
#pragma unroll
            for (int q4 = 0; q4 < 4; ++q4) {
                float s4 = (X[k4][4 * q4] + X[k4][4 * q4 + 1]) + (X[k4][4 * q4 + 2] + X[k4][4 * q4 + 3]);
                float lt = X[k4][4 * q4 + 3];
                s4 = quad_sum(s4); lt = quad_sum(lt);
                if ((r32 & 3) == 0) { const int j = 8 * k4 + 2 * q4 + h; pc4[ttl * 33 + j] = s4; pl[ttl * 33 + j] = lt; }
            }
        f32x16 o[2];
#pragma unroll
        for (int i = 0; i < 16; ++i) { o[0][i] = 0.f; o[1][i] = 0.f; }
#pragma unroll
        for (int k4 = 0; k4 < 4; ++k4)
#pragma unroll
            for (int s = 0; s < 2; ++s) {
                u32x4 w; w.x = pack2(X[k4][8 * s], X[k4][8 * s + 1]); w.y = pack2(X[k4][8 * s + 2], X[k4][8 * s + 3]);
                w.z = pack2(X[k4][8 * s + 4], X[k4][8 * s + 5]); w.w = pack2(X[k4][8 * s + 6], X[k4][8 * s + 7]);
                const bf16x8 pf = __builtin_bit_cast(bf16x8, w);
#pragma unroll
                for (int nt = 0; nt < 2; ++nt) {
                    const u16* vp = Vtc + (32 * k4 + 16 * s + 4 * h + ((lane & 15) >> 2)) * GP + 32 * nt + 16 * ((lane >> 4) & 1) + 4 * (lane & 3);
                    const s16x4 lo = tr_read(vp), hi = tr_read(vp + 8 * GP);
                    const bf16x8 vf = __builtin_shufflevector(lo, hi, 0, 1, 2, 3, 4, 5, 6, 7);
                    o[nt] = MFMA32(vf, pf, o[nt]);
                }
            }
#pragma unroll
        for (int i = 0; i < 16; ++i) { osum[0][i] = o[0][i] * gcmp; osum[1][i] = o[1][i] * gcmp; }
    }
    __syncthreads();
    if (tid < 64) {
        const int cur = qt;
        unsigned mask = 1u | (1u << cur);
        const int npick = 2;
        if (cur >= 2) {
            int p1 = -1, p2 = -1; float b1 = -1.f, b2 = -1.f;
            for (int j = 1; j < cur; ++j) {
                const float v = pc4[tid * 33 + j] + pl[tid * 33 + j - 1];
                if (v > b1) { b2 = b1; p2 = p1; b1 = v; p1 = j; }
                else if (v > b2) { b2 = v; p2 = j; }
            }
            if (p1 >= 0) mask |= 1u << p1;
            if (p2 >= 0) mask |= 1u << p2;
        }
        selm[tid] = mask;
        unsigned um = mask;
#pragma unroll
        for (int o = 1; o < 64; o <<= 1) um |= (unsigned)__shfl_xor((int)um, o);
        if (tid == 0) umw[0] = um;
    }
    __syncthreads();
    const unsigned sm = selm[ttl];
    unsigned um = umw[0];
    {
        AttnAcc st; attn_reset(st);
        const int ntile = __builtin_popcount(um);
        unsigned rem_src = um, rem_cmp = um; int kt_src = 0;
        tile_loop(lds, ntile, tid,
            [&](int) { if (rem_src) { kt_src = __builtin_ctz(rem_src); rem_src &= rem_src - 1; } const int kt = kt_src; const u16* zb = Z + ((size_t)b * SEQ + 64 * kt) * LDZ1; return TileSrc{zb + 2816 + 64 * kvh, zb + 2944 + 64 * kvh, LDZ1, LDZ1}; },
            [&](int, const u16* Kt, const u16* Vt) {
                const int ktc = __builtin_ctz(rem_cmp); rem_cmp &= rem_cmp - 1;
                const int kt = ktc, base = 64 * kt; const bool on = (sm >> kt) & 1u;
                if (__any(on)) {
                    if (kt < qt) attn_compute<2>(Kt, Vt, q, st, lane, on, [&](int) { return true; });
                    else attn_compute<0>(Kt, Vt, q, st, lane, true, [&](int kl) { return on && (base + kl <= tok); });
                }
            });
        const float mul = gsel / st.l;
#pragma unroll
        for (int i = 0; i < 16; ++i) { osum[0][i] += st.o[0][i] * mul; osum[1][i] += st.o[1][i] * mul; }
    }
    {
        AttnAcc st; attn_reset(st);
        const int kt0 = qt >= 8 ? qt - 8 : 0;
        tile_loop(lds, qt - kt0 + 1, tid,
            [&](int i) { const u16* zb = Z + ((size_t)b * SEQ + 64 * (kt0 + i)) * LDZ1; return TileSrc{zb + 3072 + 64 * kvh, zb + 3200 + 64 * kvh, LDZ1, LDZ1}; },
            [&](int i, const u16* Kt, const u16* Vt) {
                const int kt = kt0 + i, base = 64 * kt;
                if (kt < qt && kt > qt - 8) attn_compute<1>(Kt, Vt, q, st, lane, true, [&](int) { return true; });
                else attn_compute<0>(Kt, Vt, q, st, lane, true, [&](int kl) { const int s = base + kl; return s <= tok && s > tok - 512; });
            });
        const float mul = gwin / st.l;
#pragma unroll
        for (int i = 0; i < 16; ++i) { osum[0][i] += st.o[0][i] * mul; osum[1][i] += st.o[1][i] * mul; }
    }
    store_gated(WT, osum, 1.f, lane, [&](int rr) { return MIX + (rowb + (rr >> 2)) * LDMIX + 512 + 64 * (4 * kvh + (rr & 3)); });
}

DI void item_rglru(const Params& p, unsigned char* lds, int item) {
    const u16* Z = (const u16*)(p.ws + OFF_Z); u16* MIX = (u16*)(p.ws + OFF_MIX);
    float* Xs = (float*)lds;
    float* XC = (float*)(lds + 17152);
    u16* XCb = (u16*)(lds + 34560);
    u16* WrT = (u16*)(lds + 43776); u16* WiT = (u16*)(lds + 52992);
    float* Aa = (float*)(lds + 62208); float* Uu = (float*)(lds + 79616);
    u16* Gs = (u16*)(lds + 97024);
    float* segA = (float*)(lds + 105216); float* segB = (float*)(lds + 107264);
    float* carry = (float*)(lds + 109312);
    const int tid = tid_(), wid = tid >> 6, lane = tid & 63, fr = lane & 15, fq = lane >> 4;
    const int hb = item & 7, b = item >> 3;
    __syncthreads();
    {
        const float* wr = p.in[14] + (size_t)hb * 4096; const float* wi = p.in[16] + (size_t)hb * 4096;
#pragma unroll
        for (int e = 0; e < 8; ++e) { const int idx = tid + 512 * e, i = idx >> 6, j = idx & 63; WrT[j * GP + i] = f2bf(wr[idx]); WiT[j * GP + i] = f2bf(wi[idx]); }
        if (tid < 192) Xs[tid] = 0.f;
        if (tid < 64) carry[tid] = 0.f;
    }
    const int ct = tid >> 3, cc8 = (tid & 7) * 8;
    float cw[4][8], cb[8];
#pragma unroll
    for (int e = 0; e < 8; ++e) {
        cb[e] = p.in[13][64 * hb + cc8 + e];
#pragma unroll
        for (int j = 0; j < 4; ++j) cw[j][e] = p.in[12][j * 512 + 64 * hb + cc8 + e];
    }
    const int jt = wid & 3, tpair = wid >> 2;
    float sp[4], br[4], bi[4];
#pragma unroll
    for (int r = 0; r < 4; ++r) {
        const int c = 64 * hb + 16 * jt + 4 * fq + r;
        const float lam = p.in[18][c];
        sp[r] = log1pf(expf(-lam)); br[r] = p.in[15][c]; bi[r] = p.in[17][c];
    }
    const size_t zrow0 = (size_t)b * SEQ;
    u32x4 rx = *(const u32x4*)(Z + (zrow0 + ct) * LDZ0 + 1280 + 64 * hb + cc8);
    u32x4 rg = *(const u32x4*)(Z + (zrow0 + ct) * LDZ0 + 1792 + 64 * hb + cc8);
    for (int c = 0; c < 32; ++c) {
        {
            float* xr = Xs + (3 + ct) * 64 + cc8;
            *(f32x4*)xr = (f32x4){bflo(rx.x), bfhi(rx.x), bflo(rx.y), bfhi(rx.y)};
            *(f32x4*)(xr + 4) = (f32x4){bflo(rx.z), bfhi(rx.z), bflo(rx.w), bfhi(rx.w)};
            *(u32x4*)(Gs + ct * 64 + cc8) = rg;
        }
        LBAR();
        {
            const int cn = c + 1 < 32 ? c + 1 : 31;
            rx = *(const u32x4*)(Z + (zrow0 + 64 * cn + ct) * LDZ0 + 1280 + 64 * hb + cc8);
            rg = *(const u32x4*)(Z + (zrow0 + 64 * cn + ct) * LDZ0 + 1792 + 64 * hb + cc8);
        }
        __builtin_amdgcn_sched_barrier(0);
        {
            float xc[8];
#pragma unroll
            for (int e = 0; e < 8; ++e) xc[e] = cb[e];
#pragma unroll
            for (int j = 0; j < 4; ++j) {
                const f32x4 a = *(const f32x4*)(Xs + (ct + j) * 64 + cc8), bb = *(const f32x4*)(Xs + (ct + j) * 64 + cc8 + 4);
#pragma unroll
                for (int e = 0; e < 4; ++e) { xc[e] += cw[j][e] * a[e]; xc[4 + e] += cw[j][4 + e] * bb[e]; }
            }
            *(f32x4*)(XC + ct * 68 + cc8) = (f32x4){xc[0], xc[1], xc[2], xc[3]};
            *(f32x4*)(XC + ct * 68 + cc8 + 4) = (f32x4){xc[4], xc[5], xc[6], xc[7]};
            u32x4 w; w.x = pack2(xc[0], xc[1]); w.y = pack2(xc[2], xc[3]); w.z = pack2(xc[4], xc[5]); w.w = pack2(xc[6], xc[7]);
            *(u32x4*)(XCb + ct * GP + cc8) = w;
        }
        LBAR();
        {
#pragma unroll
            for (int ts = 0; ts < 2; ++ts) {
                const int tt = 2 * tpair + ts;
                f32x4 accr = {0.f, 0.f, 0.f, 0.f}, acci = {0.f, 0.f, 0.f, 0.f};
#pragma unroll
                for (int ks = 0; ks < 2; ++ks) {
                    const bf16x8 ar = *(const bf16x8*)(WrT + (16 * jt + fr) * GP + 32 * ks + 8 * fq);
                    const bf16x8 ai = *(const bf16x8*)(WiT + (16 * jt + fr) * GP + 32 * ks + 8 * fq);
                    const bf16x8 bx = *(const bf16x8*)(XCb + (16 * tt + fr) * GP + 32 * ks + 8 * fq);
                    accr = MFMA16(ar, bx, accr); acci = MFMA16(ai, bx, acci);
                }
                const int t = 16 * tt + fr;
                const f32x4 xc4 = *(const f32x4*)(XC + t * 68 + 16 * jt + 4 * fq);
                f32x4 av, uv;
#pragma unroll
                for (int r = 0; r < 4; ++r) {
                    const float rgate = sigmoidf_(accr[r] + br[r]), igate = sigmoidf_(acci[r] + bi[r]);
                    const float la = -8.f * rgate * sp[r];
                    av[r] = __expf(la); uv[r] = __builtin_amdgcn_sqrtf(fmaxf(1.f - __expf(2.f * la), 0.f)) * igate * xc4[r];
                }
                *(f32x4*)(Aa + t * 68 + 16 * jt + 4 * fq) = av; *(f32x4*)(Uu + t * 68 + 16 * jt + 4 * fq) = uv;
            }
            if (tid < 192) Xs[tid] = Xs[64 * 64 + tid];
        }
        LBAR();
        const int ch = tid & 63, seg = tid >> 6;
        float av8[8], uv8[8];
        {
            float A = 1.f, B = 0.f;
#pragma unroll
            for (int i = 0; i < 8; ++i) { av8[i] = Aa[(8 * seg + i) * 68 + ch]; uv8[i] = Uu[(8 * seg + i) * 68 + ch]; B = av8[i] * B + uv8[i]; A *= av8[i]; }
            segA[seg * 64 + ch] = A; segB[seg * 64 + ch] = B;
        }
        LBAR();
        {
            float hst = carry[(c & 1) * 64 + ch];
#pragma unroll
            for (int s = 0; s < 7; ++s) if (s < seg) hst = segA[s * 64 + ch] * hst + segB[s * 64 + ch];
#pragma unroll
            for (int i = 0; i < 8; ++i) {
                hst = av8[i] * hst + uv8[i];
                const int t = 8 * seg + i;
                MIX[(zrow0 + 64 * c + t) * LDMIX + 512 + 64 * hb + ch] = f2bf(hst * bf2f(Gs[t * 64 + ch]));
            }
            if (seg == 7) carry[((c + 1) & 1) * 64 + ch] = hst;
        }
        LBAR();
    }
}

DI void item_hgrn(const Params& p, unsigned char* lds, int item) {
    const u16* __restrict__ Z = (const u16*)(p.ws + OFF_Z); u16* __restrict__ MIX = (u16*)(p.ws + OFF_MIX);
    u16* Qs = (u16*)lds;
    u16* Ks = (u16*)(lds + 17408);
    u16* Vr = (u16*)(lds + 34816);
    u16* KhT = (u16*)(lds + 52224);
    u16* VT = (u16*)(lds + 70656);
    u16* As = (u16*)(lds + 89088);
    u16* ST = (u16*)(lds + 98304);
    float* qsum = (float*)(lds + 133120);
    float* dec = (float*)(lds + 135168);
    float* ssq = (float*)(lds + 135680);
    const int tid = tid_(), wid = tid >> 6, lane = tid & 63, fr = lane & 15, fq = lane >> 4;
    const int head = item & 3, b = item >> 2;
    const int d = tid & 127, qt = tid >> 7;
    const int lt = tid >> 3, lc = (tid & 7) * 16;
    __syncthreads();
    for (int i = tid; i < 128 * GP2 / 2; i += NTHR) ((unsigned*)ST)[i] = 0u;
    f32x4 sacc[8];
#pragma unroll
    for (int v = 0; v < 8; ++v) sacc[v] = (f32x4){0.f, 0.f, 0.f, 0.f};
    float og[4];
#pragma unroll
    for (int r = 0; r < 4; ++r) og[r] = p.in[22][16 * wid + 4 * fq + r];
    const size_t zrow0 = (size_t)b * SEQ;
    const int gcol = 1536 + 128 * head + 16 * wid + 4 * fq;
    u32x4 rq[2], rg[2], rv[2]; u32x2 gn[4];
    {
        const u16* zp = Z + (zrow0 + lt) * LDZ1 + 128 * head + lc;
        rq[0] = *(const u32x4*)zp; rq[1] = *(const u32x4*)(zp + 8);
        rg[0] = *(const u32x4*)(zp + 512); rg[1] = *(const u32x4*)(zp + 520);
        rv[0] = *(const u32x4*)(zp + 1024); rv[1] = *(const u32x4*)(zp + 1032);
#pragma unroll
        for (int tt = 0; tt < 4; ++tt) gn[tt] = *(const u32x2*)(Z + (zrow0 + 16 * tt + fr) * LDZ1 + gcol);
    }
    for (int c = 0; c < 32; ++c) {
        u32x2 gc[4];
        {
            *(u32x4*)(Qs + lt * GP2 + lc) = rq[0]; *(u32x4*)(Qs + lt * GP2 + lc + 8) = rq[1];
            *(u32x4*)(Ks + lt * GP2 + lc) = rg[0]; *(u32x4*)(Ks + lt * GP2 + lc + 8) = rg[1];
            *(u32x4*)(Vr + lt * GP2 + lc) = rv[0]; *(u32x4*)(Vr + lt * GP2 + lc + 8) = rv[1];
#pragma unroll
            for (int tt = 0; tt < 4; ++tt) gc[tt] = gn[tt];
        }
        LBAR();
        {
            const int cn = c + 1 < 32 ? c + 1 : 31;
            const u16* zp = Z + (zrow0 + 64 * cn + lt) * LDZ1 + 128 * head + lc;
            rq[0] = *(const u32x4*)zp; rq[1] = *(const u32x4*)(zp + 8);
            rg[0] = *(const u32x4*)(zp + 512); rg[1] = *(const u32x4*)(zp + 520);
            rv[0] = *(const u32x4*)(zp + 1024); rv[1] = *(const u32x4*)(zp + 1032);
#pragma unroll
            for (int tt = 0; tt < 4; ++tt) gn[tt] = *(const u32x2*)(Z + (zrow0 + 64 * cn + 16 * tt + fr) * LDZ1 + gcol);
        }
        __builtin_amdgcn_sched_barrier(0);
        float bl[16], gv[16];
        {
            float run = 0.f;
#pragma unroll
            for (int i = 0; i < 16; ++i) { gv[i] = bf2f(Ks[(16 * qt + i) * GP2 + d]); run += gv[i]; bl[i] = run; }
            qsum[qt * 128 + d] = run;
        }
        LBAR();
        {
            float off = 0.f, tot = 0.f;
#pragma unroll
            for (int qq = 0; qq < 4; ++qq) { const float s = qsum[qq * 128 + d]; tot += s; if (qq < qt) off += s; }
            unsigned khw[8], vw[8];
#pragma unroll
            for (int i2 = 0; i2 < 8; ++i2) {
                float kh[2], vv[2];
#pragma unroll
                for (int e = 0; e < 2; ++e) {
                    const int i = 2 * i2 + e;
                    const float bb = off + bl[i];
                    const float kk = 1.f - __expf(gv[i]);
                    const float qv = bf2f(Qs[(16 * qt + i) * GP2 + d]);
                    vv[e] = bf2f(Vr[(16 * qt + i) * GP2 + d]);
                    Qs[(16 * qt + i) * GP2 + d] = f2bf(qv * __expf(bb));
                    Ks[(16 * qt + i) * GP2 + d] = f2bf(kk * __expf(fminf(-bb, 80.f)));
                    kh[e] = kk * __expf(tot - bb);
                }
                khw[i2] = pack2(kh[0], kh[1]); vw[i2] = pack2(vv[0], vv[1]);
            }
            *(u32x4*)(KhT + d * GP + 16 * qt) = (u32x4){khw[0], khw[1], khw[2], khw[3]};
            *(u32x4*)(KhT + d * GP + 16 * qt + 8) = (u32x4){khw[4], khw[5], khw[6], khw[7]};
            *(u32x4*)(VT + d * GP + 16 * qt) = (u32x4){vw[0], vw[1], vw[2], vw[3]};
            *(u32x4*)(VT + d * GP + 16 * qt + 8) = (u32x4){vw[4], vw[5], vw[6], vw[7]};
            if (qt == 0) dec[d] = __expf(tot);
        }
        LBAR();
        {
            const int st = wid >> 1;
#pragma unroll
            for (int ts = 0; ts < 2; ++ts) {
                const int tt = 2 * (wid & 1) + ts;
                f32x4 acc = {0.f, 0.f, 0.f, 0.f};
                if (st <= tt) {
#pragma unroll
                    for (int ks = 0; ks < 4; ++ks) {
                        const bf16x8 a = *(const bf16x8*)(Ks + (16 * st + fr) * GP2 + 32 * ks + 8 * fq);
                        const bf16x8 bq = *(const bf16x8*)(Qs + (16 * tt + fr) * GP2 + 32 * ks + 8 * fq);
                        acc = MFMA16(a, bq, acc);
                    }
                }
                const int t = 16 * tt + fr, s0 = 16 * st + 4 * fq;
                float a4[4];
#pragma unroll
                for (int r = 0; r < 4; ++r) a4[r] = (s0 + r <= t) ? acc[r] : 0.f;
                u32x2 w; w.x = pack2(a4[0], a4[1]); w.y = pack2(a4[2], a4[3]);
                *(u32x2*)(As + t * GP + s0) = w;
            }
        }
        LBAR();
        f32x4 oacc[4];
        {
#pragma unroll
            for (int tt = 0; tt < 4; ++tt) oacc[tt] = (f32x4){0.f, 0.f, 0.f, 0.f};
#pragma unroll
            for (int ks = 0; ks < 4; ++ks) {
                const bf16x8 a = *(const bf16x8*)(ST + (16 * wid + fr) * GP2 + 32 * ks + 8 * fq);
#pragma unroll
                for (int tt = 0; tt < 4; ++tt) { const bf16x8 bq = *(const bf16x8*)(Qs + (16 * tt + fr) * GP2 + 32 * ks + 8 * fq); oacc[tt] = MFMA16(a, bq, oacc[tt]); }
            }
#pragma unroll
            for (int ks = 0; ks < 2; ++ks) {
                const bf16x8 a = *(const bf16x8*)(VT + (16 * wid + fr) * GP + 32 * ks + 8 * fq);
#pragma unroll
                for (int tt = 0; tt < 4; ++tt) { const bf16x8 ba = *(const bf16x8*)(As + (16 * tt + fr) * GP + 32 * ks + 8 * fq); oacc[tt] = MFMA16(a, ba, oacc[tt]); }
            }
#pragma unroll
            for (int tt = 0; tt < 4; ++tt) {
                float s = oacc[tt][0] * oacc[tt][0] + oacc[tt][1] * oacc[tt][1] + oacc[tt][2] * oacc[tt][2] + oacc[tt][3] * oacc[tt][3];
                s = xor32_sum(xor16_sum(s));
                if (fq == 0) ssq[wid * 64 + 16 * tt + fr] = s;
            }
        }
        LBAR();
        {
#pragma unroll
            for (int tt = 0; tt < 4; ++tt) {
                const int t = 16 * tt + fr;
                float tot = 0.f;
#pragma unroll
                for (int w = 0; w < 8; ++w) tot += ssq[w * 64 + t];
                const float inv = rsqrtf(tot * (1.f / 128.f) + EPS);
                const size_t row = zrow0 + 64 * c + t;
                const u32x2 g = gc[tt];
                u32x2 w; w.x = pack2(oacc[tt][0] * inv * og[0] * bflo(g.x), oacc[tt][1] * inv * og[1] * bfhi(g.x));
                w.y = pack2(oacc[tt][2] * inv * og[2] * bflo(g.y), oacc[tt][3] * inv * og[3] * bfhi(g.y));
                *(u32x2*)(MIX + row * LDMIX + 128 * head + 16 * wid + 4 * fq) = w;
            }
            const f32x4 d4 = *(const f32x4*)(dec + 16 * wid + 4 * fq);
#pragma unroll
            for (int v = 0; v < 8; ++v) sacc[v] = sacc[v] * d4;
#pragma unroll
            for (int ks = 0; ks < 2; ++ks) {
                const bf16x8 a = *(const bf16x8*)(KhT + (16 * wid + fr) * GP + 32 * ks + 8 * fq);
#pragma unroll
                for (int v = 0; v < 8; ++v) { const bf16x8 bv = *(const bf16x8*)(VT + (16 * v + fr) * GP + 32 * ks + 8 * fq); sacc[v] = MFMA16(a, bv, sacc[v]); }
            }
#pragma unroll
            for (int v = 0; v < 8; ++v) { u32x2 w; w.x = pack2(sacc[v][0], sacc[v][1]); w.y = pack2(sacc[v][2], sacc[v][3]); *(u32x2*)(ST + (16 * v + fr) * GP2 + 16 * wid + 4 * fq) = w; }
        }
        LBAR();
    }
}

DI void phase_inproj(const Params& p, unsigned char* lds, int layer) {
    unsigned char* ws = p.ws;
    PG8_LAS unsigned char* l3 = (PG8_LAS unsigned char*)lds;
    const int NT = layer ? 18 : 11;
    EpiZ e; e.Z = (u16*)(ws + OFF_Z); e.ldz = layer ? LDZ1 : LDZ0; e.rs = (const float*)(ws + (layer ? OFF_RSP : OFF_RS0)); e.rs4 = (layer != 0); e.layer = layer; e.p = &p;
    e.cs = (const float*)(ws + OFF_COS); e.sn = (const float*)(ws + OFF_SIN); e.tr = lds + LDS_TR + 2048 * (tid_() >> 6);
    pg8::Gemm g{(const u16*)(ws + OFF_XB), (const u16*)(ws + (layer ? OFF_WT1 : OFF_WT0)), DM};
    pg8::SchedIn S{NT, (int)(gridDim.x >> 3), (int)(blockIdx.x >> 3), (int)(blockIdx.x & 7)};
    pg8::gemm_phase<EpiZ, pg8::SchedIn, true>(l3, g, S, e);
    if (layer == 0) {
        for (int u = blockIdx.x; u < 128; u += gridDim.x) {
            const int l = u >> 6, pm = (u >> 1) & 31, pn = u & 1;
            EpiZ em; em.Z = (u16*)(ws + OFF_MKV) + (size_t)l * 8192 * 512; em.ldz = 512; em.rs = (const float*)(ws + OFF_RSM); em.layer = 2 + l; em.p = &p; em.cs = e.cs; em.sn = e.sn; em.tr = e.tr; em.rs4 = false;
            pg8::Gemm gm{(const u16*)(ws + OFF_MEMB), (const u16*)(ws + OFF_WM) + (size_t)l * 512 * 1024, DM};
            pg8::SchedOne S1{pm, pn, true};
            pg8::gemm_phase<EpiZ, pg8::SchedOne, false>(l3, gm, S1, em);
        }
        if (gridDim.x > 128) { if (blockIdx.x >= 128) prep_layer1(p, lds, blockIdx.x - 128, gridDim.x - 128); }
        else prep_layer1(p, lds, blockIdx.x, gridDim.x);
    }
}

DI void phase_outproj(const Params& p, unsigned char* lds, int layer) {
    unsigned char* ws = p.ws;
    PG8_LAS unsigned char* l3 = (PG8_LAS unsigned char*)lds;
    pg8::Gemm g{(const u16*)(ws + OFF_MIX), (const u16*)(ws + (layer ? OFF_WO1 : OFF_WO0)), LDMIX};
    const int tid = tid_();
    if (layer == 0) {
        EpiOut0 e; e.x = p.in[0]; e.out = p.out; e.xb = (u16*)(ws + OFF_XB); e.red = (float*)(lds + LDS_RED); e.tr = lds + LDS_TR + 2048 * (tid >> 6);
        e.rsp = (float*)(ws + OFF_RSP); e.par = 0; e.ppm = -1; e.ppn = 0;
        pg8::SchedOutX S{(int)(gridDim.x >> 3), (int)(blockIdx.x >> 3), (int)(blockIdx.x & 7)};
        pg8::gemm_phase<EpiOut0, pg8::SchedOutX, true>(l3, g, S, e);
        __syncthreads();
        { const int lane = tid & 63, wid = tid >> 6; e.flush(wid >> 2, wid & 3, lane & 15, lane >> 4); }
        __syncthreads();
    }
    if (layer == 1) {
        EpiOut1 e; e.out = p.out; e.xb = (const u16*)(ws + OFF_XB); e.tr = lds + LDS_TR + 2048 * (tid >> 6);
        pg8::SchedOutX S{(int)(gridDim.x >> 3), (int)(blockIdx.x >> 3), (int)(blockIdx.x & 7)};
        pg8::gemm_phase<EpiOut1, pg8::SchedOutX, true>(l3, g, S, e);
    }
}

DI void compress_unit(const Params& p, unsigned char* lds, int u) {
    unsigned char* ws = p.ws;
    const int kv = u & 1, pm = u >> 1;
    EpiCmp e; e.bias = (const float*)(ws + OFF_BIAS) + 128 * kv; e.w2 = kv ? p.in[32] : p.in[30]; e.gain = p.in[24]; e.dst = (u16*)(ws + (kv ? OFF_VC : OFF_KC)); e.isk = (kv == 0);
    e.cs = (const float*)(ws + OFF_COS); e.sn = (const float*)(ws + OFF_SIN);
    const u16* Zc = (const u16*)(ws + OFF_Z) + (kv ? 2688 : 2560);
    gemm_unit<EpiCmp, true>(lds, Zc, LDZ1, 0, (const u16*)(ws + (kv ? OFF_W1V : OFF_W1K)), 2048, 32, pm, 0, e);
}

DI void phase_mix0(const Params& p, unsigned char* lds) {
    for (int it = blockIdx.x; it < 256; it += gridDim.x) item_rglru(p, lds, it);
    for (int it = blockIdx.x; it < 2048; it += gridDim.x) item_swa(p, lds, it);
    for (int it = blockIdx.x; it < 1024; it += gridDim.x) item_mem(p, lds, it, 0);
}

__shared__ int s_ticket;
DI void phase_mix1(const Params& p, unsigned char* lds, int ci) {
    unsigned* ctr = (unsigned*)(p.ws + OFF_CTR) + ci;
    bool cmp_ready = false;
    unsigned nxt = 0;
    if (threadIdx.x == 0) nxt = atomicAdd(ctr, 1u);
    for (;;) {
        __syncthreads();
        if (threadIdx.x == 0) { s_ticket = (int)nxt; nxt = atomicAdd(ctr, 1u); }
        __syncthreads();
        const int tk = s_ticket;
        if (tk >= 128 + 64 + 1024 + 2048) break;
        if (tk < 128) item_hgrn(p, lds, tk);
        else if (tk < 192) {
            compress_unit(p, lds, tk - 128);
            __threadfence(); __syncthreads();
            if (threadIdx.x == 0) atomicAdd(ctr + 8, 1u);
        }
        else if (tk < 192 + 1024) item_mem(p, lds, tk - 192, 1);
        else {
            if (!cmp_ready) {
                if (threadIdx.x == 0) { while (__hip_atomic_load(ctr + 8, __ATOMIC_RELAXED, __HIP_MEMORY_SCOPE_AGENT) < 64u) __builtin_amdgcn_s_sleep(8); }
                __syncthreads(); __threadfence(); cmp_ready = true;
            }
            item_nsa(p, lds, tk - 192 - 1024);
        }
    }
}


DI void gbar(unsigned* bar, unsigned k) {
    __syncthreads();
    if (threadIdx.x == 0) {
        __builtin_amdgcn_fence(__ATOMIC_RELEASE, "agent"); asm volatile("s_waitcnt vmcnt(0)" ::: "memory");
        atomicAdd(bar, 1u);
        const unsigned target = k * gridDim.x;
        while (__hip_atomic_load(bar, __ATOMIC_RELAXED, __HIP_MEMORY_SCOPE_AGENT) < target) __builtin_amdgcn_s_sleep(2);
        __builtin_amdgcn_fence(__ATOMIC_ACQUIRE, "agent"); asm volatile("s_waitcnt vmcnt(0)" ::: "memory");
    }
    __syncthreads();
}

constexpr int NPHASE = 8;
__global__ void __launch_bounds__(NTHR) mega(Params p) {
    extern __shared__ __attribute__((aligned(16))) unsigned char lds[];
    cg::grid_group grid = cg::this_grid();
#ifndef PROBE_MASK
#define PROBE_MASK 0
#endif
    unsigned* bar = (unsigned*)(p.ws + OFF_BAR); unsigned nbar = 0;
#define PH(k, call0, call1) if (p.ph_lo <= (k) && (k) < p.ph_hi) { call0; if ((PROBE_MASK >> (k)) & 1) { grid.sync(); call1; } if ((k) + 1 < p.ph_hi) { if ((k) == 0) grid.sync(); else gbar(bar, ++nbar); } }
    PH(0, phase_prep(p, lds), phase_prep(p, lds))
    PH(1, phase_inproj(p, lds, 0), phase_inproj(p, lds, 0))
    PH(2, phase_mix0(p, lds), phase_mix0(p, lds))
    PH(3, phase_outproj(p, lds, 0), phase_outproj(p, lds, 0))
    PH(4, phase_inproj(p, lds, 1), phase_inproj(p, lds, 1))
    PH(6, phase_mix1(p, lds, 0), phase_mix1(p, lds, 1))
    PH(7, phase_outproj(p, lds, 1), phase_outproj(p, lds, 1))
#undef PH
}

extern "C" void kernel_launch(void* const* d_in, const int* in_sizes, int n_in, void* d_out, int out_size, void* d_ws, size_t ws_size, hipStream_t stream) {
    static int grid = 0;
    if (grid == 0) {
        if (n_in != 33 || ws_size < WS_END) { fprintf(stderr, "kernel_launch: unexpected n_in %d / ws_size %zu (need %zu)\n", n_in, ws_size, (size_t)WS_END); grid = -1; return; }
        int dev = 0, cus = 0, per_cu = 0;
        hipGetDevice(&dev);
        hipDeviceGetAttribute(&cus, hipDeviceAttributeMultiprocessorCount, dev);
        if (hipFuncSetAttribute((const void*)mega, hipFuncAttributeMaxDynamicSharedMemorySize, LDS_BYTES) != hipSuccess) { fprintf(stderr, "kernel_launch: hipFuncSetAttribute failed\n"); grid = -1; return; }
        hipOccupancyMaxActiveBlocksPerMultiprocessor(&per_cu, (const void*)mega, NTHR, LDS_BYTES);
        if (per_cu < 1) { fprintf(stderr, "kernel_launch: occupancy query says %d blocks per CU\n", per_cu); per_cu = 1; }
        (void)hipGetLastError();
        grid = cus;
        if (grid % 8) grid -= grid % 8;
    }
    if (grid < 0) return;
    Params p{};
    for (int i = 0; i < 33; ++i) p.in[i] = (const float*)d_in[i];
    p.out = (float*)d_out; p.ws = (unsigned char*)d_ws;
#if ONE_LAUNCH
    p.ph_lo = 0; p.ph_hi = NPHASE;
    void* args[] = {&p};
    hipError_t e = hipLaunchCooperativeKernel((const void*)mega, dim3(grid), dim3(NTHR), args, LDS_BYTES, stream);
    if (e != hipSuccess) fprintf(stderr, "cooperative launch failed: %s (grid %d)\n", hipGetErrorString(e), grid);
#else
    for (int ph = 0; ph < NPHASE; ++ph) {
        p.ph_lo = ph; p.ph_hi = ph + 1;
        hipLaunchKernelGGL(mega, dim3(grid), dim3(NTHR), LDS_BYTES, stream, p);
    }
#endif
}
```
